# Optimizing an MI355X kernel written in HIP

```python
import jax, jax.numpy as jnp
from jax import lax
import numpy as np

D_MODEL = 1024
BATCH = 8
SEQ = 2048
DEPTH = 1
DEC_BATCH = 128
DEC_SEQ = 1
PAST_LEN = 16384
PAGE_SIZE = 128

N_META = 16
CHUNK = 64
HA = 4
DKA = 128
DVA = 128
CONV_A = 4
C_A = 2 * HA * DKA + HA * DVA
HB = 4
DKB = 128
DVB = 256
GATE_RANK = 16
GLA_GATE_NORM = 16.0
D_FF = 2816
CONV_F = 3
EPS = 1e-6

PROJ_SIZES = [HA * DKA, HA * DKA, HA * DVA, HA * DVA, HA, HA,
              HB * DKB, HB * DKB, HB * DVB, HB * DVB, GATE_RANK, D_MODEL, D_MODEL]
D_IN = int(sum(PROJ_SIZES))

kernel_name = "hybrid_gdn_gla_convffn_meta_step"


def rmsnorm(x, w):
    xf = x.astype(jnp.float32)
    y = xf * lax.rsqrt(jnp.mean(xf * xf, axis=-1, keepdims=True) + EPS)
    return (y * w.astype(jnp.float32)).astype(x.dtype)


def l2norm(a):
    return a * lax.rsqrt(jnp.sum(a * a, axis=-1, keepdims=True) + EPS)


def causal_dwconv(x, w, prev, bias=None):
    width = w.shape[0]
    t = x.shape[1]
    xp = jnp.concatenate([prev.astype(x.dtype), x], axis=1)
    y = xp[:, 0:t] * w[0]
    for i in range(1, width):
        y = y + xp[:, i:i + t] * w[i]
    if bias is not None:
        y = y + bias
    return y, xp[:, t:]


def _to_chunks(a):
    b, t, h = a.shape[:3]
    a = a.reshape((b, t // CHUNK, CHUNK, h) + a.shape[3:])
    return jnp.moveaxis(a, (1, 3), (0, 2))


def _from_chunks(o):
    n, b, h, c, d = o.shape
    return jnp.transpose(o, (1, 0, 3, 2, 4)).reshape(b, n * c, h, d)


def _delta_chunk_step(S, inp):
    q, k, v, g, beta = inp
    causal = jnp.tril(jnp.ones((CHUNK, CHUNK), bool))
    strict = jnp.tril(jnp.ones((CHUNK, CHUNK), bool), -1)
    G = jnp.cumsum(g, axis=-1)
    decay = jnp.exp(jnp.where(causal, G[..., :, None] - G[..., None, :], -jnp.inf))
    kb = k * beta[..., None]
    M = jnp.where(strict, jnp.einsum('bhid,bhjd->bhij', kb, k) * decay, 0.0)
    eye = jnp.broadcast_to(jnp.eye(CHUNK, dtype=M.dtype), M.shape)
    T = lax.linalg.triangular_solve(eye + M, eye, left_side=True, lower=True)
    u = jnp.einsum('bhij,bhje->bhie', T, v * beta[..., None])
    w = jnp.einsum('bhij,bhjd->bhid', T, kb * jnp.exp(G)[..., None])
    v_new = u - jnp.einsum('bhcd,bhde->bhce', w, S)
    attn = jnp.einsum('bhid,bhjd->bhij', q, k) * decay
    o = (jnp.einsum('bhcd,bhde->bhce', q * jnp.exp(G)[..., None], S)
         + jnp.einsum('bhij,bhje->bhie', attn, v_new))
    gl = G[..., -1]
    S = (S * jnp.exp(gl)[..., None, None]
         + jnp.einsum('bhcd,bhce->bhde', k * jnp.exp(gl[..., None] - G)[..., None], v_new))
    return S, o


def _delta_chunked(q, k, v, g, beta, s0):
    inp = tuple(_to_chunks(a) for a in (q, k, v, g, beta))
    S, o = lax.scan(_delta_chunk_step, s0.astype(jnp.float32), inp)
    return _from_chunks(o), S


def _delta_recurrent(q, k, v, g, beta, s0):
    def step(S, inp):
        qt, kt, vt, gt, bt = inp
        S = S * jnp.exp(gt)[..., None, None]
        err = vt - jnp.einsum('bhk,bhkv->bhv', kt, S)
        S = S + jnp.einsum('bhk,bhv->bhkv', kt, err * bt[..., None])
        return S, jnp.einsum('bhk,bhkv->bhv', qt, S)
    inp = tuple(jnp.moveaxis(a, 1, 0) for a in (q, k, v, g, beta))
    S, o = lax.scan(step, s0.astype(jnp.float32), inp)
    return jnp.moveaxis(o, 0, 1), S


def _gla_chunk_step(S, inp):
    q, k, v, lg = inp
    causal = jnp.tril(jnp.ones((CHUNK, CHUNK), bool))
    Bc = jnp.cumsum(lg, axis=-2)
    diff = Bc[:, :, :, None, :] - Bc[:, :, None, :, :]
    dec = jnp.exp(jnp.where(causal[..., None], diff, -jnp.inf))
    attn = jnp.einsum('bhid,bhjd,bhijd->bhij', q, k, dec)
    o = (jnp.einsum('bhcd,bhde->bhce', q * jnp.exp(Bc), S)
         + jnp.einsum('bhij,bhje->bhie', attn, v))
    bl = Bc[:, :, -1]
    S = (S * jnp.exp(bl)[..., None]
         + jnp.einsum('bhcd,bhce->bhde', k * jnp.exp(bl[:, :, None] - Bc), v))
    return S, o


def _gla_chunked(q, k, v, lg, s0):
    inp = tuple(_to_chunks(a) for a in (q, k, v, lg))
    S, o = lax.scan(_gla_chunk_step, s0.astype(jnp.float32), inp)
    return _from_chunks(o), S


def _gla_recurrent(q, k, v, lg, s0):
    def step(S, inp):
        qt, kt, vt, lt = inp
        S = S * jnp.exp(lt)[..., None] + jnp.einsum('bhk,bhv->bhkv', kt, vt)
        return S, jnp.einsum('bhk,bhkv->bhv', qt, S)
    inp = tuple(jnp.moveaxis(a, 1, 0) for a in (q, k, v, lg))
    S, o = lax.scan(step, s0.astype(jnp.float32), inp)
    return jnp.moveaxis(o, 0, 1), S


def _block(x, s_a0, conv_a_prev, s_b0, conv_f_prev, chunked,
           norm_mix, w_in, w_conv_a, a_log, dt_bias, w_gk2, b_gk, onorm_a, onorm_b,
           w_a_out, w_b_out, w_o, norm_ffn, w_ffn_in, w_conv_f, b_conv_f, w_ffn_out):
    f32 = jnp.float32
    bsz, t, _ = x.shape
    h = rmsnorm(x, norm_mix)
    idx = np.cumsum(PROJ_SIZES)[:-1].tolist()
    (qa, ka, va, za, ba, aa, qb, kb, vb, rb, lrb, gate_a, gate_b) = jnp.split(h @ w_in, idx, axis=-1)
    qkv_a, conv_a_new = causal_dwconv(jnp.concatenate([qa, ka, va], -1), w_conv_a, conv_a_prev)
    qkv_a = jax.nn.silu(qkv_a.astype(f32))
    qa, ka, va = jnp.split(qkv_a, [HA * DKA, 2 * HA * DKA], axis=-1)
    qa = l2norm(qa.reshape(bsz, t, HA, DKA)) * (DKA ** -0.5)
    ka = l2norm(ka.reshape(bsz, t, HA, DKA))
    va = va.reshape(bsz, t, HA, DVA)
    beta_a = jax.nn.sigmoid(ba.astype(f32))
    g_a = -jnp.exp(a_log.astype(f32)) * jax.nn.softplus(aa.astype(f32) + dt_bias.astype(f32))
    qb = qb.astype(f32).reshape(bsz, t, HB, DKB) * (DKB ** -0.5)
    kb = kb.astype(f32).reshape(bsz, t, HB, DKB)
    vb = vb.astype(f32).reshape(bsz, t, HB, DVB)
    lg_b = (jax.nn.log_sigmoid((lrb @ w_gk2 + b_gk).astype(f32)) / GLA_GATE_NORM).reshape(bsz, t, HB, DKB)
    if chunked:
        lead = (-N_META) % CHUNK
        pad = lambda a: jnp.pad(a, [(0, 0), (lead, 0)] + [(0, 0)] * (a.ndim - 2))
        o_a, s_a = _delta_chunked(pad(qa), pad(ka), pad(va), pad(g_a), pad(beta_a), s_a0)
        o_b, s_b = _gla_chunked(pad(qb), pad(kb), pad(vb), pad(lg_b), s_b0)
        o_a = o_a[:, lead:]
        o_b = o_b[:, lead:]
    else:
        o_a, s_a = _delta_recurrent(qa, ka, va, g_a, beta_a, s_a0)
        o_b, s_b = _gla_recurrent(qb, kb, vb, lg_b, s_b0)
    o_a = rmsnorm(o_a, onorm_a) * jax.nn.silu(za.astype(f32).reshape(bsz, t, HA, DVA))
    o_b = rmsnorm(o_b, onorm_b) * jax.nn.silu(rb.astype(f32).reshape(bsz, t, HB, DVB))
    y_a = o_a.reshape(bsz, t, HA * DVA).astype(x.dtype) @ w_a_out
    y_b = o_b.reshape(bsz, t, HB * DVB).astype(x.dtype) @ w_b_out
    mix = jax.nn.sigmoid(gate_a) * y_a + jax.nn.sigmoid(gate_b) * y_b
    x = x + mix @ w_o
    h = rmsnorm(x, norm_ffn)
    u, gf = jnp.split(h @ w_ffn_in, [D_FF], axis=-1)
    u, conv_f_new = causal_dwconv(u, w_conv_f, conv_f_prev, b_conv_f)
    x = x + (jax.nn.gelu(u) * gf) @ w_ffn_out
    return x, s_a.astype(x.dtype), conv_a_new, s_b.astype(x.dtype), conv_f_new


def setup_inputs(seed: int = 0) -> dict:
    key = jax.random.key(seed)
    ks = jax.random.split(key, 32)
    nrm = lambda k, s, sc: jax.random.normal(k, s, jnp.float32) * sc
    gain = lambda k, s: 1.0 + 0.01 * jax.random.normal(k, s, jnp.float32)
    dt = jnp.exp(jax.random.uniform(ks[10], (DEPTH, HA), jnp.float32) * (jnp.log(0.1) - jnp.log(1e-3)) + jnp.log(1e-3))
    return {
        'x_prompt': nrm(ks[0], (BATCH, SEQ, D_MODEL), 1.0),
        'x_sample': nrm(ks[1], (DEC_BATCH, DEC_SEQ, D_MODEL), 1.0),
        'state_delta': nrm(ks[2], (DEPTH, DEC_BATCH, HA, DKA, DVA), 0.1),
        'state_delta_conv': nrm(ks[3], (DEPTH, DEC_BATCH, CONV_A - 1, C_A), 1.0),
        'state_gla': nrm(ks[4], (DEPTH, DEC_BATCH, HB, DKB, DVB), 0.1),
        'state_ffn_conv': nrm(ks[5], (DEPTH, DEC_BATCH, CONV_F - 1, D_FF), 1.0),
        'meta_tokens': nrm(ks[6], (N_META, D_MODEL), 1.0),
        'norm_mix': gain(ks[7], (DEPTH, D_MODEL)),
        'w_in': nrm(ks[8], (DEPTH, D_MODEL, D_IN), D_MODEL ** -0.5),
        'w_conv_a': nrm(ks[9], (DEPTH, CONV_A, C_A), CONV_A ** -0.5),
        'a_log': jnp.log(jax.random.uniform(ks[11], (DEPTH, HA), jnp.float32, 1.0, 16.0)),
        'dt_bias': dt + jnp.log(-jnp.expm1(-dt)),
        'w_gk2': nrm(ks[12], (DEPTH, GATE_RANK, HB * DKB), GATE_RANK ** -0.5),
        'b_gk': nrm(ks[13], (DEPTH, HB * DKB), 0.1),
        'onorm_a': gain(ks[14], (DEPTH, DVA)),
        'onorm_b': gain(ks[15], (DEPTH, DVB)),
        'w_a_out': nrm(ks[16], (DEPTH, HA * DVA, D_MODEL), (HA * DVA) ** -0.5),
        'w_b_out': nrm(ks[17], (DEPTH, HB * DVB, D_MODEL), (HB * DVB) ** -0.5),
        'w_o': nrm(ks[18], (DEPTH, D_MODEL, D_MODEL), D_MODEL ** -0.5),
        'norm_ffn': gain(ks[19], (DEPTH, D_MODEL)),
        'w_ffn_in': nrm(ks[20], (DEPTH, D_MODEL, 2 * D_FF), D_MODEL ** -0.5),
        'w_conv_f': nrm(ks[21], (DEPTH, CONV_F, D_FF), CONV_F ** -0.5),
        'b_conv_f': nrm(ks[22], (DEPTH, D_FF), 0.01),
        'w_ffn_out': nrm(ks[23], (DEPTH, D_FF, D_MODEL), D_FF ** -0.5),
        'norm_final': gain(ks[24], (D_MODEL,)),
    }


def reference(x_prompt, x_sample, state_delta, state_delta_conv, state_gla, state_ffn_conv,
              meta_tokens, norm_mix, w_in, w_conv_a, a_log, dt_bias, w_gk2, b_gk, onorm_a, onorm_b,
              w_a_out, w_b_out, w_o, norm_ffn, w_ffn_in, w_conv_f, b_conv_f, w_ffn_out, norm_final):
    bsz = x_prompt.shape[0]
    meta = jnp.broadcast_to(meta_tokens.astype(x_prompt.dtype)[None], (bsz, N_META, D_MODEL))
    xp = jnp.concatenate([meta, x_prompt], axis=1)
    xs = x_sample
    new_p = ([], [], [], [])
    new_s = ([], [], [], [])
    for l in range(DEPTH):
        lw = (norm_mix[l], w_in[l], w_conv_a[l], a_log[l], dt_bias[l], w_gk2[l], b_gk[l],
              onorm_a[l], onorm_b[l], w_a_out[l], w_b_out[l], w_o[l], norm_ffn[l],
              w_ffn_in[l], w_conv_f[l], b_conv_f[l], w_ffn_out[l])
        xp, sa, ca, sb, cf = _block(
            xp, jnp.zeros((bsz, HA, DKA, DVA), jnp.float32),
            jnp.zeros((bsz, CONV_A - 1, C_A), xp.dtype),
            jnp.zeros((bsz, HB, DKB, DVB), jnp.float32),
            jnp.zeros((bsz, CONV_F - 1, D_FF), xp.dtype), True, *lw)
        for lst, val in zip(new_p, (sa, ca, sb, cf)):
            lst.append(val)
        xs, sa, ca, sb, cf = _block(xs, state_delta[l], state_delta_conv[l], state_gla[l],
                                    state_ffn_conv[l], False, *lw)
        for lst, val in zip(new_s, (sa, ca, sb, cf)):
            lst.append(val)
    y_prompt = rmsnorm(xp, norm_final)[:, N_META:]
    y_sample = rmsnorm(xs, norm_final)
    return (y_prompt, y_sample,
            jnp.stack(new_p[0]), jnp.stack(new_p[1]), jnp.stack(new_p[2]), jnp.stack(new_p[3]),
            jnp.stack(new_s[0]), jnp.stack(new_s[1]), jnp.stack(new_s[2]), jnp.stack(new_s[3]))
```

```cpp
#include <hip/hip_runtime.h>
#include <hip/hip_cooperative_groups.h>
#include <cstdio>
#include <cstdint>
namespace cg = cooperative_groups;
namespace pg8 {
#define PG8_LAS __attribute__((address_space(3)))
typedef unsigned short bf16_t;
typedef short bf16x8 __attribute__((ext_vector_type(8)));
typedef float f32x4 __attribute__((ext_vector_type(4)));
typedef unsigned u32x4 __attribute__((ext_vector_type(4)));
constexpr int BM = 256, BK = 64, HALF = 128, HTB = HALF * BK * 2  , STAGE_BYTES = 8 * HTB, NXCD = 8, WGM = 8;

__host__ __device__ __forceinline__ int lds_byte(int r, int c) { const int st = (r >> 4) * 2 + (c >> 5), rr = r & 15, cc = c & 31, ob = rr * 64 + cc * 2; return st * 1024 + (ob ^ (((ob >> 9) & 1) << 5)); }
__host__ __device__ __forceinline__ void stage_rc(int b, int& R, int& C) { const int st = b / 1024, sb = b % 1024, swz = sb ^ (((sb >> 9) & 1) << 5); R = (st >> 1) * 16 + swz / 64; C = (st & 1) * 32 + (swz % 64) / 2; }
__host__ __device__ __forceinline__ int perm32(int rho) { const int n = rho >> 4, i = rho & 15; return 8 * (i >> 2) + 4 * n + (i & 3); }

struct Unit { int pm, pn; };
struct Gemm { const bf16_t* A; const bf16_t* Bt; int M, N, K; };

struct StaticOrder {
    int nM, nN, nwg, G, c;
    __host__ __device__ void init(int M, int N, int G_, int c_) { nM = M / BM; nN = N / BM; nwg = nM * nN; G = G_; c = c_; }
    __host__ __device__ bool next(int i, Unit& u) const {
        const long L = (long)i * G + c; if (L >= nwg) return false;
        int wgid = (int)L; { const int q = nwg / NXCD, r = nwg % NXCD, xcd = wgid % NXCD, off = wgid / NXCD; wgid = (xcd < r ? xcd * (q + 1) : r * (q + 1) + (xcd - r) * q) + off; }
        const int nig = WGM * nN, gid = wgid / nig, fm = gid * WGM, gsz = (nM - fm) < WGM ? (nM - fm) : WGM;
        u.pm = fm + ((wgid % nig) % gsz); u.pn = (wgid % nig) / gsz; return true;
    }
    __device__ __forceinline__ void a_ready(const Unit&) const {}
    __device__ __forceinline__ void done(const Unit&) const {}
};

template <class F> struct Epi8 {
    static constexpr bool PERM = true, AFTER_DRAIN = false;
    F f;
    __device__ __forceinline__ void operator()(const f32x4 (&acc)[2][2][4][2], const Unit& u, int wr, int wc, int fr, int fq) const {
#pragma unroll
        for (int ai = 0; ai < 2; ++ai)
#pragma unroll
            for (int m = 0; m < 4; ++m) {
                const int row = u.pm * BM + ai * HALF + wr * 64 + m * 16 + fr;
                float ss = 0.f;
#pragma unroll
                for (int bj = 0; bj < 2; ++bj) { const int col = u.pn * BM + bj * HALF + wc * 32 + 8 * fq; ss += f(row, col, acc[ai][bj][m][0], acc[ai][bj][m][1]); }
                if (F::HAS_SS) { ss += __shfl_xor(ss, 16); ss += __shfl_xor(ss, 32); if (fq == 0) f.add_ss(row, ss); }
            }
    }
};
template <class Epi, class Sched, bool ALIGN_EPI = false, bool SP2 = false>
__device__ __forceinline__ void gemm_phase(PG8_LAS unsigned char* lds, const Gemm g, const Sched& S, const Epi& E) {
    const int tid = threadIdx.x, wid = __builtin_amdgcn_readfirstlane(tid >> 6), lane = tid & 63, wr = wid >> 2, wc = wid & 3, fr = lane & 15, fq = lane >> 4;
    const int K = g.K, nt = K / BK;
    unsigned voffA[2], voffB[2];
#pragma unroll
    for (int i = 0; i < 2; ++i) { int R, C; stage_rc(tid * 16 + i * 8192, R, C); const int Rb = Epi::PERM ? ((R & ~31) + perm32(R & 31)) : R;
        voffA[i] = (unsigned)(R * K + C) * 2u; voffB[i] = (unsigned)(Rb * K + C) * 2u; }
    const size_t kstep = (size_t)(BK * 2);
    const size_t hstep = (size_t)HALF * K * 2;
    const size_t tstep = 2 * hstep;
    const unsigned ldsw = (unsigned)wid * 1024u;
    const int aoff = lds_byte(wr * 64 + fr, fq * 8), boff = lds_byte(wc * 32 + fr, fq * 8);
#define PG8_SA(b, h) (((b) * 2 + (h)) * HTB)
#define PG8_SB(b, h) ((4 + (b) * 2 + (h)) * HTB)
#define PG8_STAGE(bufoff, gbase, voff) do { _Pragma("unroll") for (int _i = 0; _i < 2; ++_i) \
        __builtin_amdgcn_global_load_lds((const unsigned*)((const char*)(gbase) + (voff)[_i]), (PG8_LAS unsigned*)(lds + (bufoff) + ldsw + _i * 8192), 16, 0, 0); } while (0)
#define PG8_LDA(dst, b, h) do { _Pragma("unroll") for (int m = 0; m < 4; ++m) _Pragma("unroll") for (int k = 0; k < 2; ++k) dst[m][k] = *(const PG8_LAS bf16x8*)(lds + PG8_SA(b, h) + aoff + m * 2048 + k * 1024); } while (0)
#define PG8_LDB(dst, b, h) do { _Pragma("unroll") for (int n = 0; n < 2; ++n) _Pragma("unroll") for (int k = 0; k < 2; ++k) dst[n][k] = *(const PG8_LAS bf16x8*)(lds + PG8_SB(b, h) + boff + n * 2048 + k * 1024); } while (0)
#define PG8_MMA(ai, bj, At, Bt) do { __builtin_amdgcn_s_setprio(1); _Pragma("unroll") for (int m = 0; m < 4; ++m) _Pragma("unroll") for (int n = 0; n < 2; ++n) _Pragma("unroll") for (int k = 0; k < 2; ++k) \
        acc[ai][bj][m][n] = __builtin_amdgcn_mfma_f32_16x16x32_bf16(Bt[n][k], At[m][k], acc[ai][bj][m][n], 0, 0, 0); __builtin_amdgcn_s_setprio(0); } while (0)
#define PG8_WAIT_V(n) asm volatile("s_waitcnt vmcnt(" #n ")" ::: "memory")
#define PG8_WAIT_L(n) asm volatile("s_waitcnt lgkmcnt(" #n ")" ::: "memory")
#define PG8_BAR __builtin_amdgcn_s_barrier()
#define PG8_SCHED __builtin_amdgcn_sched_barrier(0)
    Unit cur, nxt; int ui = 0;
    if (!S.next(0, cur)) return;
    f32x4 acc[2][2][4][2];
#pragma unroll
    for (int a = 0; a < 2; ++a)
#pragma unroll
        for (int b = 0; b < 2; ++b)
#pragma unroll
            for (int m = 0; m < 4; ++m)
#pragma unroll
                for (int n = 0; n < 2; ++n) acc[a][b][m][n] = (f32x4){0.f, 0.f, 0.f, 0.f};
    bf16x8 At[4][2], B0[2][2], B1[2][2];
    const char* cA = (const char*)g.A + (size_t)cur.pm * tstep; const char* cB = (const char*)g.Bt + (size_t)cur.pn * tstep;
    S.a_ready(cur);
    if constexpr (SP2) {
        PG8_STAGE(PG8_SB(0, 0), cB, voffB); PG8_STAGE(PG8_SB(0, 1), cB + hstep, voffB); PG8_STAGE(PG8_SA(0, 0), cA, voffA); PG8_STAGE(PG8_SA(0, 1), cA + hstep, voffA);
        if (wr == 1) PG8_BAR;
        PG8_WAIT_V(2); PG8_BAR;
        PG8_STAGE(PG8_SB(1, 0), cB + kstep, voffB); PG8_STAGE(PG8_SA(1, 0), cA + kstep, voffA); PG8_STAGE(PG8_SB(1, 1), cB + hstep + kstep, voffB);
        PG8_WAIT_V(6); PG8_BAR;
    } else {
        PG8_STAGE(PG8_SB(0, 0), cB, voffB); PG8_STAGE(PG8_SA(0, 0), cA, voffA); PG8_STAGE(PG8_SB(0, 1), cB + hstep, voffB); PG8_STAGE(PG8_SA(0, 1), cA + hstep, voffA);
        if (wr == 1) PG8_BAR;
        PG8_WAIT_V(4); PG8_BAR;
        PG8_STAGE(PG8_SB(1, 0), cB + kstep, voffB); PG8_STAGE(PG8_SA(1, 0), cA + kstep, voffA); PG8_STAGE(PG8_SB(1, 1), cB + hstep + kstep, voffB);
        PG8_WAIT_V(6); PG8_BAR;
    }
    for (;;) {
        const bool has_next = S.next(ui + 1, nxt);
        const char* nA = has_next ? (const char*)g.A + (size_t)nxt.pm * tstep : cA; const char* nB = has_next ? (const char*)g.Bt + (size_t)nxt.pn * tstep : cB;
        for (int t = 0; t < nt; t += 2) {
            const bool last = (t == nt - 2);
            const char* a1 = cA + (size_t)(t + 1) * kstep;
            const char* a2 = last ? nA : cA + (size_t)(t + 2) * kstep; const char* b2 = last ? nB : cB + (size_t)(t + 2) * kstep;
            const char* a3 = a2 + kstep; const char* b3 = b2 + kstep;
            if (last && has_next) S.a_ready(nxt);
            if constexpr (SP2) {
            PG8_LDB(B0, 0, 0); PG8_LDB(B1, 0, 1); PG8_SCHED; PG8_LDA(At, 0, 0); PG8_STAGE(PG8_SA(1, 1), a1 + hstep, voffA);
            PG8_WAIT_V(8); PG8_WAIT_L(0); PG8_BAR; PG8_MMA(0, 0, At, B0); PG8_MMA(0, 1, At, B1); PG8_BAR; PG8_SCHED;
            PG8_LDA(At, 0, 1); PG8_STAGE(PG8_SB(0, 0), b2, voffB); PG8_STAGE(PG8_SB(0, 1), b2 + hstep, voffB); PG8_STAGE(PG8_SA(0, 0), a2, voffA);
            PG8_WAIT_V(8); PG8_WAIT_L(0); PG8_BAR; PG8_MMA(1, 0, At, B0); PG8_MMA(1, 1, At, B1); PG8_BAR; PG8_SCHED;
            PG8_LDB(B0, 1, 0); PG8_LDB(B1, 1, 1); PG8_SCHED; PG8_LDA(At, 1, 0); PG8_STAGE(PG8_SA(0, 1), a2 + hstep, voffA);
            PG8_WAIT_V(8); PG8_WAIT_L(0); PG8_BAR; PG8_MMA(0, 0, At, B0); PG8_MMA(0, 1, At, B1); PG8_BAR; PG8_SCHED;
            PG8_LDA(At, 1, 1); PG8_STAGE(PG8_SB(1, 0), b3, voffB); PG8_STAGE(PG8_SB(1, 1), b3 + hstep, voffB); PG8_STAGE(PG8_SA(1, 0), a3, voffA);
            PG8_WAIT_V(8); PG8_WAIT_L(0); PG8_BAR; PG8_MMA(1, 0, At, B0); PG8_MMA(1, 1, At, B1); PG8_BAR; PG8_SCHED;
            } else {
            PG8_LDB(B0, 0, 0); PG8_SCHED; PG8_LDA(At, 0, 0); PG8_STAGE(PG8_SA(1, 1), a1 + hstep, voffA);
            PG8_WAIT_L(8); PG8_BAR; PG8_WAIT_L(0); PG8_MMA(0, 0, At, B0); PG8_BAR; PG8_SCHED;
            PG8_LDB(B1, 0, 1); PG8_STAGE(PG8_SB(0, 0), b2, voffB);
            PG8_BAR; PG8_WAIT_L(0); PG8_MMA(0, 1, At, B1); PG8_BAR;
            PG8_LDA(At, 0, 1); PG8_STAGE(PG8_SA(0, 0), a2, voffA);
            PG8_BAR; PG8_WAIT_L(0); PG8_MMA(1, 0, At, B0); PG8_BAR; PG8_SCHED;
            PG8_STAGE(PG8_SB(0, 1), b2 + hstep, voffB);
            PG8_WAIT_V(6); PG8_BAR; PG8_MMA(1, 1, At, B1); PG8_BAR;
            PG8_LDB(B0, 1, 0); PG8_SCHED; PG8_LDA(At, 1, 0); PG8_STAGE(PG8_SA(0, 1), a2 + hstep, voffA);
            PG8_WAIT_L(8); PG8_BAR; PG8_WAIT_L(0); PG8_MMA(0, 0, At, B0); PG8_BAR; PG8_SCHED;
            PG8_LDB(B1, 1, 1); PG8_STAGE(PG8_SB(1, 0), b3, voffB);
            PG8_BAR; PG8_WAIT_L(0); PG8_MMA(0, 1, At, B1); PG8_BAR;
            PG8_LDA(At, 1, 1); PG8_STAGE(PG8_SA(1, 0), a3, voffA);
            PG8_BAR; PG8_WAIT_L(0); PG8_MMA(1, 0, At, B0); PG8_BAR; PG8_SCHED;
            PG8_STAGE(PG8_SB(1, 1), b3 + hstep, voffB);
            PG8_WAIT_V(6); PG8_BAR; PG8_MMA(1, 1, At, B1); PG8_BAR;
            }
        }
        if constexpr (ALIGN_EPI) { if (wr == 0) PG8_BAR; }
        if constexpr (!Epi::AFTER_DRAIN) { E(acc, cur, wr, wc, fr, fq); S.done(cur); }
        if (!has_next) break;
#pragma unroll
        for (int a = 0; a < 2; ++a)
#pragma unroll
            for (int b = 0; b < 2; ++b)
#pragma unroll
                for (int m = 0; m < 4; ++m)
#pragma unroll
                    for (int n = 0; n < 2; ++n) acc[a][b][m][n] = (f32x4){0.f, 0.f, 0.f, 0.f};
        cur = nxt; cA = nA; cB = nB; ++ui;
        if constexpr (ALIGN_EPI) { if (wr == 1) PG8_BAR; }
    }
    PG8_WAIT_V(0);
    if constexpr (!ALIGN_EPI) { if (wr == 0) PG8_BAR; }
    PG8_BAR;
    if constexpr (Epi::AFTER_DRAIN) { E.fused(acc, cur, wr, wc, fr, fq, lds, wid, lane); S.done(cur); }
#undef PG8_SA
#undef PG8_SB
#undef PG8_STAGE
#undef PG8_LDA
#undef PG8_LDB
#undef PG8_MMA
#undef PG8_WAIT_V
#undef PG8_WAIT_L
#undef PG8_BAR
#undef PG8_SCHED
}
}

#define LAS __attribute__((address_space(3)))
typedef unsigned short bf16_t;
typedef short bf16x8 __attribute__((ext_vector_type(8)));
typedef float f32x4 __attribute__((ext_vector_type(4)));
typedef unsigned u32x4 __attribute__((ext_vector_type(4)));
typedef unsigned u32x2 __attribute__((ext_vector_type(2)));

constexpr int D = 1024, NB = 8, SEQ = 2048, NDEC = 128;
constexpr int RMAIN = 16384, RMETA0 = 16384, RDEC0 = 16512, R = 16640, RP = 16512;
constexpr int DIN = 7192, CA = 1536, DFF = 2816, NCH = 33;
constexpr int NA = 3840, LDA_ = 3584, NBW = 3584;
constexpr int NITEM = NB * 4 * NCH;
constexpr float EPS = 1e-6f;
constexpr int NTHR = 512, LDS_BYTES = 147456;

constexpr size_t O_YP = 0, O_YS = 16777216, O_DP = 16908288, O_DCP = 17432576, O_GP = 17469440, O_FCP = 18518016,
                 O_DS = 18563072, O_DCS = 26951680, O_GS = 27541504, O_FCS = 44318720, O_END = 45039616;
constexpr size_t DS_HN = 0, DS_OA = DS_HN + (size_t)R * 1024 * 2, DS_SMALL = DS_OA + (size_t)R * 512 * 2, DS_ATTB = DS_SMALL + (size_t)R * 32 * 4,
                 DS_EGL = DS_ATTB + (size_t)NITEM * 8192, DS_EBL = DS_EGL + 8192, DS_END = DS_EBL + (size_t)NITEM * 128 * 4;
static_assert(DS_END <= 16777216ull * 4, "d_out scratch");
constexpr size_t MiB = 1u << 20;
constexpr size_t WS_WTA = 0, WS_WTB = WS_WTA + (size_t)NA * 1024 * 2, WS_WA = WS_WTB + (size_t)NBW * 1024 * 2, WS_WB = WS_WA + 1024 * 512 * 2,
                 WS_WO = WS_WB + 1024 * 1024 * 2, WS_WF1 = WS_WO + 1024 * 1024 * 2, WS_WF2 = WS_WF1 + (size_t)5632 * 1024 * 2,
                 WS_CTL = WS_WF2 + (size_t)1024 * 2816 * 2, WS_BIG = WS_CTL + MiB / 4;
constexpr size_t WS_SS2 = WS_CTL, WS_SS3 = WS_CTL + 128 * 1024;
constexpr size_t WS_PROJA = WS_BIG, WS_QT = WS_PROJA + (size_t)R * LDA_ * 2, WS_KT = WS_QT + (size_t)RP * 512 * 2, WS_WW = WS_KT + (size_t)RP * 512 * 2,
                 WS_UU = WS_WW + (size_t)RP * 512 * 2, WS_ATTA = WS_UU + (size_t)RP * 512 * 2, WS_OB = WS_ATTA + (size_t)NITEM * 8192, WS_END1 = WS_OB + (size_t)R * 1024 * 2;
static_assert(WS_END1 <= 256 * MiB, "ws map 1");
constexpr size_t WS_Z = WS_BIG, WS_SG = WS_Z + (size_t)R * 1536 * 2;
static_assert(WS_SG + (size_t)R * 2048 * 2 <= WS_QT, "ws map 2");
constexpr size_t WS_MIX = WS_QT;
constexpr size_t WS_HN2 = WS_OB;
constexpr size_t WS_U = WS_BIG, WS_GF = WS_U + (size_t)R * DFF * 2;
static_assert(WS_GF + (size_t)R * DFF * 2 <= WS_HN2, "ws map 3");
static_assert(WS_MIX + (size_t)R * 1024 * 2 <= WS_OB, "ws map 4");

struct Params { const float* in[25]; float* out; unsigned char* ws; int ph_lo, ph_hi; };
enum { I_XP = 0, I_XS, I_SD, I_SDC, I_SG, I_SFC, I_META, I_NMIX, I_WIN, I_WCA, I_ALOG, I_DTB, I_WGK2, I_BGK, I_ONA, I_ONB, I_WAO, I_WBO, I_WO, I_NFFN, I_WFI, I_WCF, I_BCF, I_WFO, I_NFIN };

__device__ __forceinline__ unsigned f2bf(float f) { unsigned u = __builtin_bit_cast(unsigned, f); return (u + 0x7fffu + ((u >> 16) & 1u)) >> 16; }
__device__ __forceinline__ unsigned pk2(float lo, float hi) { return f2bf(lo) | (f2bf(hi) << 16); }
__device__ __forceinline__ float bflo(unsigned w) { return __builtin_bit_cast(float, w << 16); }
__device__ __forceinline__ float bfhi(unsigned w) { return __builtin_bit_cast(float, w & 0xffff0000u); }
__device__ __forceinline__ float bf2f(bf16_t h) { return __builtin_bit_cast(float, ((unsigned)h) << 16); }
__device__ __forceinline__ void unpack8(u32x4 w, float* f) { f[0] = bflo(w.x); f[1] = bfhi(w.x); f[2] = bflo(w.y); f[3] = bfhi(w.y); f[4] = bflo(w.z); f[5] = bfhi(w.z); f[6] = bflo(w.w); f[7] = bfhi(w.w); }
__device__ __forceinline__ u32x4 pack8(const float* f) { u32x4 w; w.x = pk2(f[0], f[1]); w.y = pk2(f[2], f[3]); w.z = pk2(f[4], f[5]); w.w = pk2(f[6], f[7]); return w; }
__device__ __forceinline__ float wave_sum(float v) {
#pragma unroll
    for (int o = 1; o < 64; o <<= 1) v += __shfl_xor(v, o);
    return v;
}
__device__ __forceinline__ float sigmoidf_(float x) { return 1.f / (1.f + __expf(-x)); }
__device__ __forceinline__ float siluf_(float x) { return x / (1.f + __expf(-x)); }
__device__ __forceinline__ float softplusf_(float x) { return fmaxf(x, 0.f) + log1pf(__expf(-fabsf(x))); }
__device__ __forceinline__ float gelu_tanh(float x) { const float u = 0.7978845608028654f * (x + 0.044715f * x * x * x); const float e = __expf(2.f * u); const float t = 1.f - 2.f / (e + 1.f); return 0.5f * x * (1.f + t); }
#define LDS_WAIT() asm volatile("s_waitcnt lgkmcnt(0)" ::: "memory")
#define MFMA16(a, b, c) __builtin_amdgcn_mfma_f32_16x16x32_bf16(a, b, c, 0, 0, 0)
__device__ __forceinline__ bf16x8 lfrag(const LAS bf16_t* base, int row, int stride, int k0, int q) { return *(const LAS bf16x8*)(base + row * stride + k0 + 8 * q); }

__device__ __forceinline__ const float* xrow_ptr(const Params& p, int row) {
    if (row < RMAIN) return p.in[I_XP] + (size_t)row * D;
    if (row < RDEC0) return p.in[I_META] + (size_t)((row - RMETA0) & 15) * D;
    return p.in[I_XS] + (size_t)(row - RDEC0) * D;
}
__device__ __forceinline__ int prow(int b, int c, int ii) {
    if (c == 0) return ii >= 48 ? RMETA0 + b * 16 + (ii - 48) : -1;
    if (ii >= 0 || c >= 2) return b * SEQ + 64 * (c - 1) + ii;
    return RMETA0 + b * 16 + 16 + ii;
}
__device__ __forceinline__ long yslot(int row) { if (row < RMAIN) return (long)O_YP + (long)row * D; if (row >= RDEC0) return (long)O_YS + (long)(row - RDEC0) * D; return -1; }

__device__ __forceinline__ void transpose_item(const float* W, int ldW, int col0, int K, bf16_t* WT, int row_off, int nblk, LAS float* scr, int item, int lane) {
    const int kb = item / nblk, nb = item % nblk, k0 = 64 * kb, n0 = 32 * nb;
#pragma unroll 8
    for (int i = 0; i < 32; ++i) { const int kk = 2 * i + (lane >> 5); scr[kk * 33 + (lane & 31)] = W[(size_t)(k0 + kk) * ldW + col0 + n0 + (lane & 31)]; }
    LDS_WAIT();
    const int c = lane & 7;
#pragma unroll
    for (int j = 0; j < 4; ++j) { const int n = (lane >> 3) + 8 * j; const LAS float* s = scr + (8 * c) * 33 + n;
        u32x4 o; o.x = pk2(s[0 * 33], s[1 * 33]); o.y = pk2(s[2 * 33], s[3 * 33]); o.z = pk2(s[4 * 33], s[5 * 33]); o.w = pk2(s[6 * 33], s[7 * 33]);
        *(u32x4*)(WT + (size_t)(row_off + n0 + n) * K + k0 + 8 * c) = o; }
    LDS_WAIT();
}
struct Seg { const float* W; int ldW, col0, K, ncols; bf16_t* WT; int row_off; };

__device__ __forceinline__ void p0_prologue(const Params& p, LAS unsigned char* lds) {
    const int tid = threadIdx.x, lane = tid & 63, wave = tid >> 6;
    const int gw = blockIdx.x * 8 + wave, NGW = gridDim.x * 8;
    unsigned char* ws = p.ws;
    LAS float* scr = (LAS float*)(lds + wave * 16384);
    bf16_t* WTA = (bf16_t*)(ws + WS_WTA); bf16_t* WTB = (bf16_t*)(ws + WS_WTB);
    const float* win = p.in[I_WIN];
    for (int sg = 0; sg < 11; ++sg) {
        Seg s;
        switch (sg) {
            case 0: s = Seg{win, DIN, 0, 1024, 1536, WTA, 0}; break;
            case 1: s = Seg{win, DIN, 2056, 1024, 1024, WTA, 1536}; break;
            case 2: s = Seg{win, DIN, 3080, 1024, 1024, WTA, 2560}; break;
            case 3: s = Seg{win, DIN, 1536, 1024, 512, WTB, 0}; break;
            case 4: s = Seg{win, DIN, 4104, 1024, 1024, WTB, 512}; break;
            case 5: s = Seg{win, DIN, 5144, 1024, 2048, WTB, 1536}; break;
            case 6: s = Seg{p.in[I_WAO], 1024, 0, 512, 1024, (bf16_t*)(ws + WS_WA), 0}; break;
            case 7: s = Seg{p.in[I_WBO], 1024, 0, 1024, 1024, (bf16_t*)(ws + WS_WB), 0}; break;
            case 8: s = Seg{p.in[I_WO], 1024, 0, 1024, 1024, (bf16_t*)(ws + WS_WO), 0}; break;
            case 9: s = Seg{p.in[I_WFI], 5632, 0, 1024, 5632, (bf16_t*)(ws + WS_WF1), 0}; break;
            default: s = Seg{p.in[I_WFO], 1024, 0, 2816, 1024, (bf16_t*)(ws + WS_WF2), 0}; break;
        }
        const int nblk = s.ncols / 32, nit = (s.K / 64) * nblk;
        for (int it = gw; it < nit; it += NGW) transpose_item(s.W, s.ldW, s.col0, s.K, s.WT, s.row_off, nblk, scr, it, lane);
    }
    const int gt = blockIdx.x * NTHR + tid, NGT = gridDim.x * NTHR;
    for (int e = gt; e < 256 * 1024; e += NGT) {
        const int c = e >> 10, k = e & 1023; float v = 0.f;
        if (c < 8) v = win[(size_t)k * DIN + 2048 + c]; else if (c < 24) v = win[(size_t)k * DIN + 5128 + (c - 8)];
        WTA[(size_t)(3584 + c) * 1024 + k] = (bf16_t)f2bf(v);
    }
    for (int e = gt; e < 2 * 32768; e += NGT) ((float*)(ws + WS_CTL))[e] = 0.f;
    bf16_t* HN = (bf16_t*)((unsigned char*)p.out + DS_HN);
    const float* nw = p.in[I_NMIX];
    for (int row = gw; row < R; row += NGW) {
        const f32x4* xr = (const f32x4*)xrow_ptr(p, row) + lane;
        f32x4 v[4]; float s = 0.f;
#pragma unroll
        for (int j = 0; j < 4; ++j) { v[j] = xr[64 * j]; s += (v[j].x * v[j].x + v[j].y * v[j].y) + (v[j].z * v[j].z + v[j].w * v[j].w); }
        const float rstd = rsqrtf(wave_sum(s) * (1.f / D) + EPS);
        u32x2* o = (u32x2*)(HN + (size_t)row * D) + lane;
#pragma unroll
        for (int j = 0; j < 4; ++j) { const f32x4 w = ((const f32x4*)nw)[lane + 64 * j]; u32x2 q; q.x = pk2(v[j].x * rstd * w.x, v[j].y * rstd * w.y); q.y = pk2(v[j].z * rstd * w.z, v[j].w * rstd * w.w); o[64 * j] = q; }
    }
}

struct FA {
    static constexpr bool HAS_SS = false;
    bf16_t* PA; float* SM;
    __device__ __forceinline__ float operator()(int row, int col, f32x4 a, f32x4 b) const {
        if (col < LDA_) { u32x4 w; w.x = pk2(a.x, a.y); w.y = pk2(a.z, a.w); w.z = pk2(b.x, b.y); w.w = pk2(b.z, b.w); *(u32x4*)(PA + (size_t)row * LDA_ + col) = w; }
        else { const int c = col - LDA_; if (c < 24) { float* o = SM + (size_t)row * 32 + c; *(f32x4*)o = a; *(f32x4*)(o + 4) = b; } }
        return 0.f;
    }
    __device__ __forceinline__ void add_ss(int, float) const {}
};
struct FB {
    static constexpr bool HAS_SS = false;
    bf16_t* Z; bf16_t* SGp;
    __device__ __forceinline__ float operator()(int row, int col, f32x4 a, f32x4 b) const {
        if (col < 1536) { u32x4 w; w.x = pk2(a.x, a.y); w.y = pk2(a.z, a.w); w.z = pk2(b.x, b.y); w.w = pk2(b.z, b.w); *(u32x4*)(Z + (size_t)row * 1536 + col) = w; }
        else { u32x4 w; w.x = pk2(sigmoidf_(a.x), sigmoidf_(a.y)); w.y = pk2(sigmoidf_(a.z), sigmoidf_(a.w)); w.z = pk2(sigmoidf_(b.x), sigmoidf_(b.y)); w.w = pk2(sigmoidf_(b.z), sigmoidf_(b.w));
               *(u32x4*)(SGp + (size_t)row * 2048 + (col - 1536)) = w; }
        return 0.f;
    }
    __device__ __forceinline__ void add_ss(int, float) const {}
};
template <int SECOND> struct FMix {
    static constexpr bool HAS_SS = false;
    const bf16_t* SGp; bf16_t* MIX;
    __device__ __forceinline__ float operator()(int row, int col, f32x4 a, f32x4 b) const {
        float g[8], v[8] = {a.x, a.y, a.z, a.w, b.x, b.y, b.z, b.w};
        unpack8(*(const u32x4*)(SGp + (size_t)row * 2048 + SECOND * 1024 + col), g);
        u32x4* mp = (u32x4*)(MIX + (size_t)row * 1024 + col);
        if (SECOND) { float m[8]; unpack8(*mp, m);
#pragma unroll
            for (int i = 0; i < 8; ++i) v[i] = m[i] + g[i] * v[i]; }
        else {
#pragma unroll
            for (int i = 0; i < 8; ++i) v[i] = g[i] * v[i]; }
        *mp = pack8(v);
        return 0.f;
    }
    __device__ __forceinline__ void add_ss(int, float) const {}
};
struct FX2 {
    static constexpr bool HAS_SS = true;
    const float* xp_; const float* meta_; const float* xs_; float* out_; const float* nffn_; bf16_t* HN2; float* SS2;
    __device__ __forceinline__ float operator()(int row, int col, f32x4 a, f32x4 b) const {
        const float* xr = (row < RMAIN ? xp_ + (size_t)row * D : (row < RDEC0 ? meta_ + (size_t)((row - RMETA0) & 15) * D : xs_ + (size_t)(row - RDEC0) * D)) + col;
        const f32x4 x0 = *(const f32x4*)xr, x1 = *(const f32x4*)(xr + 4);
        a = a + x0; b = b + x1;
        const long ys = yslot(row);
        if (ys >= 0) { float* o = out_ + ys + col; *(f32x4*)o = a; *(f32x4*)(o + 4) = b; }
        const float* nw = nffn_ + col; const f32x4 w0 = *(const f32x4*)nw, w1 = *(const f32x4*)(nw + 4);
        u32x4 w; w.x = pk2(a.x * w0.x, a.y * w0.y); w.y = pk2(a.z * w0.z, a.w * w0.w); w.z = pk2(b.x * w1.x, b.y * w1.y); w.w = pk2(b.z * w1.z, b.w * w1.w);
        *(u32x4*)(HN2 + (size_t)row * 1024 + col) = w;
        return (a.x * a.x + a.y * a.y) + (a.z * a.z + a.w * a.w) + (b.x * b.x + b.y * b.y) + (b.z * b.z + b.w * b.w);
    }
    __device__ __forceinline__ void add_ss(int row, float s) const { atomicAdd(SS2 + row, s); }
};
struct FF1 {
    static constexpr bool HAS_SS = false;
    const float* SS2; bf16_t* U; bf16_t* GF;
    __device__ __forceinline__ float operator()(int row, int col, f32x4 a, f32x4 b) const {
        const float rs = rsqrtf(SS2[row] * (1.f / D) + EPS);
        u32x4 w; w.x = pk2(a.x * rs, a.y * rs); w.y = pk2(a.z * rs, a.w * rs); w.z = pk2(b.x * rs, b.y * rs); w.w = pk2(b.z * rs, b.w * rs);
        bf16_t* o = col < DFF ? U + (size_t)row * DFF + col : GF + (size_t)row * DFF + (col - DFF);
        *(u32x4*)o = w;
        return 0.f;
    }
    __device__ __forceinline__ void add_ss(int, float) const {}
};
struct FF2 {
    static constexpr bool HAS_SS = true;
    float* out; float* SS3;
    __device__ __forceinline__ float operator()(int row, int col, f32x4 a, f32x4 b) const {
        const long ys = yslot(row); if (ys < 0) return 0.f;
        float* o = out + ys + col;
        a = a + *(const f32x4*)o; b = b + *(const f32x4*)(o + 4);
        *(f32x4*)o = a; *(f32x4*)(o + 4) = b;
        return (a.x * a.x + a.y * a.y) + (a.z * a.z + a.w * a.w) + (b.x * b.x + b.y * b.y) + (b.z * b.z + b.w * b.w);
    }
    __device__ __forceinline__ void add_ss(int row, float s) const { atomicAdd(SS3 + row, s); }
};

template <class F> __device__ __forceinline__ void thin_gemm(LAS unsigned char* lds, const bf16_t* A, const bf16_t* Bt, int K, int N, int row0, const F& f) {
    const int tid = threadIdx.x, lane = tid & 63, wave = tid >> 6, fr = lane & 15, fq = lane >> 4;
    LAS float* red = (LAS float*)lds;
    const int nct = N / 32, ntiles = 8 * nct, nks = K / 32;
    for (int tile = blockIdx.x; tile < ntiles; tile += gridDim.x) {
        const int rt = tile & 7, ct = tile >> 3;
        f32x4 acc[2][2];
#pragma unroll
        for (int i = 0; i < 2; ++i)
#pragma unroll
            for (int j = 0; j < 2; ++j) acc[i][j] = (f32x4){0.f, 0.f, 0.f, 0.f};
        const bf16_t* ap = A + (size_t)(row0 + rt * 32 + fr) * K + 8 * fq;
        const bf16_t* bp = Bt + (size_t)(ct * 32 + fr) * K + 8 * fq;
        for (int ks = wave; ks < nks; ks += 8) {
            const bf16x8 a0 = *(const bf16x8*)(ap + ks * 32), a1 = *(const bf16x8*)(ap + (size_t)16 * K + ks * 32);
            const bf16x8 b0 = *(const bf16x8*)(bp + ks * 32), b1 = *(const bf16x8*)(bp + (size_t)16 * K + ks * 32);
            acc[0][0] = MFMA16(b0, a0, acc[0][0]); acc[0][1] = MFMA16(b1, a0, acc[0][1]);
            acc[1][0] = MFMA16(b0, a1, acc[1][0]); acc[1][1] = MFMA16(b1, a1, acc[1][1]);
        }
        __syncthreads();
#pragma unroll
        for (int i = 0; i < 2; ++i)
#pragma unroll
            for (int j = 0; j < 2; ++j)
#pragma unroll
                for (int r = 0; r < 4; ++r) red[wave * 1056 + (16 * i + fr) * 33 + 16 * j + 4 * fq + r] = acc[i][j][r];
        __syncthreads();
        if (tid < 128) {
            const int rr = tid >> 2, c8 = tid & 3; float v[8];
#pragma unroll
            for (int e = 0; e < 8; ++e) { float s = 0.f;
#pragma unroll
                for (int w = 0; w < 8; ++w) s += red[w * 1056 + rr * 33 + c8 * 8 + e];
                v[e] = s; }
            const int row = row0 + rt * 32 + rr;
            const float ss = f(row, ct * 32 + c8 * 8, (f32x4){v[0], v[1], v[2], v[3]}, (f32x4){v[4], v[5], v[6], v[7]});
            if (F::HAS_SS) f.add_ss(row, ss);
        }
    }
    __syncthreads();
}

constexpr int SQ = 136, SK = 72, SM_ = 68;
constexpr int L_QS = 0, L_KS = L_QS + 64 * SQ * 2, L_KBS = L_KS + 64 * SQ * 2, L_VBT = L_KBS + 64 * SQ * 2, L_KGT = L_VBT + 128 * SK * 2,
              L_MF = L_KGT + 128 * SK * 2, L_TF = L_MF + 64 * SM_ * 4, L_TB = L_TF + 64 * SM_ * 4, L_G = L_TB + 64 * SK * 2, L_P = L_G + 1024, L_END2 = L_P + 16 * 17 * 4;
static_assert(L_END2 <= LDS_BYTES, "P2 LDS");

__device__ __forceinline__ void p2_delta_item(const Params& p, LAS unsigned char* lds, int item) {
    const int tid = threadIdx.x, lane = tid & 63, wave = tid >> 6, fr = lane & 15, fq = lane >> 4;
    const int c = item % NCH, bh = item / NCH, h = bh & 3, b = bh >> 2;
    unsigned char* ws = p.ws;
    const bf16_t* PA = (const bf16_t*)(ws + WS_PROJA);
    const float* SMALL = (const float*)((unsigned char*)p.out + DS_SMALL);
    LAS bf16_t* qs = (LAS bf16_t*)(lds + L_QS); LAS bf16_t* ks = (LAS bf16_t*)(lds + L_KS); LAS bf16_t* kbs = (LAS bf16_t*)(lds + L_KBS);
    LAS bf16_t* vbT = (LAS bf16_t*)(lds + L_VBT); LAS bf16_t* kgT = (LAS bf16_t*)(lds + L_KGT);
    LAS float* Mf = (LAS float*)(lds + L_MF); LAS float* Tf = (LAS float*)(lds + L_TF); LAS bf16_t* Tb = (LAS bf16_t*)(lds + L_TB);
    LAS float* gs = (LAS float*)(lds + L_G); LAS float* Gs = gs + 64; LAS float* Pf = (LAS float*)(lds + L_P);
    const int i = tid >> 3, cgp = tid & 7;
    const int row = prow(b, c, i);
    float beta = 0.f, g = 0.f;
    if (row >= 0) {
        beta = sigmoidf_(SMALL[(size_t)row * 32 + h]);
        g = -__expf(p.in[I_ALOG][h]) * softplusf_(SMALL[(size_t)row * 32 + 4 + h] + p.in[I_DTB][h]);
    }
    if (cgp == 0) gs[i] = g;
    __syncthreads();
    if (wave == 0) {
        float x = gs[lane];
#pragma unroll
        for (int o = 1; o < 64; o <<= 1) { const float t = __shfl_up(x, o); if (lane >= o) x += t; }
        Gs[lane] = x;
    }
    __syncthreads();
    const float Gi = Gs[i], Gl = Gs[63];
    const float eg = __expf(Gi), egl = __expf(Gl - Gi);
    if (tid == 0) ((float*)((unsigned char*)p.out + DS_EGL))[item] = __expf(Gl);
    int rws[4];
#pragma unroll
    for (int j = 0; j < 4; ++j) rws[j] = prow(b, c, i - 3 + j);
#pragma unroll 1
    for (int sel = 0; sel < 3; ++sel) {
        const int ch0 = sel * 512 + h * 128 + 16 * cgp;
        float y[16];
#pragma unroll
        for (int e = 0; e < 16; ++e) y[e] = 0.f;
#pragma unroll
        for (int j = 0; j < 4; ++j) {
            if (rws[j] >= 0) {
                const u32x4* xp = (const u32x4*)(PA + (size_t)rws[j] * LDA_ + ch0);
                float x[16]; unpack8(xp[0], x); unpack8(xp[1], x + 8);
                const f32x4* wc = (const f32x4*)(p.in[I_WCA] + j * CA + ch0);
#pragma unroll
                for (int e4 = 0; e4 < 4; ++e4) { const f32x4 w = wc[e4]; y[4 * e4] += w.x * x[4 * e4]; y[4 * e4 + 1] += w.y * x[4 * e4 + 1]; y[4 * e4 + 2] += w.z * x[4 * e4 + 2]; y[4 * e4 + 3] += w.w * x[4 * e4 + 3]; }
                if (j == 3 && c == NCH - 1 && i >= 61) {
                    f32x4* o = (f32x4*)(p.out + O_DCP + (size_t)(b * 3 + (i - 61)) * CA + ch0);
#pragma unroll
                    for (int e4 = 0; e4 < 4; ++e4) o[e4] = (f32x4){x[4 * e4], x[4 * e4 + 1], x[4 * e4 + 2], x[4 * e4 + 3]};
                }
            }
            asm volatile("" ::: "memory");
        }
        float ss = 0.f;
#pragma unroll
        for (int e = 0; e < 16; ++e) { y[e] = siluf_(y[e]); ss += y[e] * y[e]; }
        ss += __shfl_xor(ss, 1); ss += __shfl_xor(ss, 2); ss += __shfl_xor(ss, 4);
        float t[16];
        if (sel == 0) {
            const float rq = rsqrtf(ss + EPS) * 0.08838834764831845f;
#pragma unroll
            for (int e = 0; e < 16; ++e) y[e] *= rq;
            *(LAS u32x4*)(qs + i * SQ + 16 * cgp) = pack8(y); *(LAS u32x4*)(qs + i * SQ + 16 * cgp + 8) = pack8(y + 8);
            if (row >= 0) {
#pragma unroll
                for (int e = 0; e < 16; ++e) t[e] = y[e] * eg;
                u32x4* o = (u32x4*)((bf16_t*)(ws + WS_QT) + (size_t)row * 512 + h * 128 + 16 * cgp); o[0] = pack8(t); o[1] = pack8(t + 8);
            }
        } else if (sel == 1) {
            const float rk = rsqrtf(ss + EPS);
#pragma unroll
            for (int e = 0; e < 16; ++e) y[e] *= rk;
            *(LAS u32x4*)(ks + i * SQ + 16 * cgp) = pack8(y); *(LAS u32x4*)(ks + i * SQ + 16 * cgp + 8) = pack8(y + 8);
            if (row >= 0) {
#pragma unroll
                for (int e = 0; e < 16; ++e) t[e] = y[e] * egl;
                u32x4* o = (u32x4*)((bf16_t*)(ws + WS_KT) + (size_t)row * 512 + h * 128 + 16 * cgp); o[0] = pack8(t); o[1] = pack8(t + 8);
            }
#pragma unroll
            for (int e = 0; e < 16; ++e) t[e] = y[e] * beta;
            *(LAS u32x4*)(kbs + i * SQ + 16 * cgp) = pack8(t); *(LAS u32x4*)(kbs + i * SQ + 16 * cgp + 8) = pack8(t + 8);
#pragma unroll
            for (int e = 0; e < 16; ++e) kgT[(16 * cgp + e) * SK + i] = (bf16_t)f2bf(t[e] * eg);
        } else {
#pragma unroll
            for (int e = 0; e < 16; ++e) vbT[(16 * cgp + e) * SK + i] = (bf16_t)f2bf(y[e] * beta);
        }
    }
    __syncthreads();
    for (int id = wave * 4; id < wave * 4 + 4; ++id) {
        const int which = id >> 4, ti = (id & 15) >> 2, tj = id & 3;
        if (tj > ti) {
            if (which == 0) { *(LAS f32x4*)(Mf + (16 * ti + fr) * SM_ + 16 * tj + 4 * fq) = (f32x4){0.f, 0.f, 0.f, 0.f}; }
            else { *(u32x2*)((bf16_t*)(ws + WS_ATTA) + (size_t)item * 4096 + (16 * ti + fr) * 64 + 16 * tj + 4 * fq) = (u32x2){0u, 0u}; }
            continue;
        }
        f32x4 acc = {0.f, 0.f, 0.f, 0.f};
        const LAS bf16_t* ya = which == 0 ? kbs : qs;
#pragma unroll
        for (int k0 = 0; k0 < 128; k0 += 32) acc = MFMA16(lfrag(ks, 16 * tj + fr, SQ, k0, fq), lfrag(ya, 16 * ti + fr, SQ, k0, fq), acc);
        const int ii = 16 * ti + fr, j0 = 16 * tj + 4 * fq;
        const float gi = Gs[ii];
        float o[4];
#pragma unroll
        for (int r = 0; r < 4; ++r) { const int jj = j0 + r; const bool keep = which == 0 ? (ii > jj) : (ii >= jj); o[r] = keep ? acc[r] * __expf(gi - Gs[jj]) : 0.f; }
        if (which == 0) *(LAS f32x4*)(Mf + ii * SM_ + j0) = (f32x4){o[0], o[1], o[2], o[3]};
        else { u32x2 w; w.x = pk2(o[0], o[1]); w.y = pk2(o[2], o[3]); *(u32x2*)((bf16_t*)(ws + WS_ATTA) + (size_t)item * 4096 + ii * 64 + j0) = w; }
    }
    __syncthreads();
    if (tid < 64) {
        const int blk = tid >> 4, j = tid & 15; float x[16];
#pragma unroll
        for (int r = 0; r < 16; ++r) {
            float s = (r == j) ? 1.f : 0.f;
#pragma unroll
            for (int m = 0; m < 16; ++m) if (m < r) s -= Mf[(16 * blk + r) * SM_ + 16 * blk + m] * x[m];
            x[r] = s;
            asm volatile("" ::: "memory");
        }
#pragma unroll
        for (int r = 0; r < 16; ++r) Tf[(16 * blk + r) * SM_ + 16 * blk + j] = x[r];
    }
    __syncthreads();
    for (int dlev = 1; dlev < 4; ++dlev)
        for (int bi = dlev; bi < 4; ++bi) {
            const int bj = bi - dlev;
            if (tid < 256) {
                const int r = tid >> 4, cc = tid & 15; float s = 0.f;
                for (int kb = bj; kb < bi; ++kb)
#pragma unroll
                    for (int m = 0; m < 16; ++m) s += Mf[(16 * bi + r) * SM_ + 16 * kb + m] * Tf[(16 * kb + m) * SM_ + 16 * bj + cc];
                Pf[r * 17 + cc] = s;
            }
            __syncthreads();
            if (tid < 256) {
                const int r = tid >> 4, cc = tid & 15; float s = 0.f;
#pragma unroll
                for (int m = 0; m < 16; ++m) s += Tf[(16 * bi + r) * SM_ + 16 * bi + m] * Pf[m * 17 + cc];
                Tf[(16 * bi + r) * SM_ + 16 * bj + cc] = -s;
            }
            __syncthreads();
        }
    {
        const int r = tid >> 3, c0 = (tid & 7) * 8; float t[8];
#pragma unroll
        for (int e = 0; e < 8; ++e) { const int cc = c0 + e; t[e] = ((cc >> 4) <= (r >> 4)) ? Tf[r * SM_ + cc] : 0.f; if ((cc >> 4) == (r >> 4) && cc > r) t[e] = 0.f; }
        *(LAS u32x4*)(Tb + r * SK + c0) = pack8(t);
    }
    __syncthreads();
    for (int id = wave * 8; id < wave * 8 + 8; ++id) {
        const int which = id >> 5, ti = (id & 31) >> 3, te = id & 7;
        const LAS bf16_t* xa = which == 0 ? vbT : kgT;
        f32x4 acc = {0.f, 0.f, 0.f, 0.f};
#pragma unroll
        for (int k0 = 0; k0 < 64; k0 += 32) acc = MFMA16(lfrag(xa, 16 * te + fr, SK, k0, fq), lfrag(Tb, 16 * ti + fr, SK, k0, fq), acc);
        const int ri = prow(b, c, 16 * ti + fr);
        if (ri >= 0) { u32x2 w; w.x = pk2(acc[0], acc[1]); w.y = pk2(acc[2], acc[3]);
            *(u32x2*)((bf16_t*)(ws + (which == 0 ? WS_UU : WS_WW)) + (size_t)ri * 512 + h * 128 + 16 * te + 4 * fq) = w; }
    }
    __syncthreads();
}

__device__ __forceinline__ void p2_gla_item(const Params& p, LAS unsigned char* lds, int item) {
    const int tid = threadIdx.x, lane = tid & 63, wave = tid >> 6, fr = lane & 15, fq = lane >> 4;
    const int c = item % NCH, bh = item / NCH, h = bh & 3, b = bh >> 2;
    unsigned char* ws = p.ws;
    bf16_t* PA = (bf16_t*)(ws + WS_PROJA);
    const float* SMALL = (const float*)((unsigned char*)p.out + DS_SMALL);
    LAS bf16_t* qs = (LAS bf16_t*)(lds + L_QS); LAS bf16_t* ks = (LAS bf16_t*)(lds + L_KS);
    const int i = lane, row = prow(b, c, i), d0 = 16 * wave;
    LAS float* W2s = (LAS float*)(lds + L_MF);
    for (int e = tid; e < 2048; e += NTHR) W2s[e] = p.in[I_WGK2][(e >> 7) * 512 + h * 128 + (e & 127)];
    if (tid < 128) W2s[2048 + tid] = p.in[I_BGK][h * 128 + tid];
    __syncthreads();
    float bc[16];
    if (row >= 0) {
        float lr[16];
        const f32x4* lp = (const f32x4*)(SMALL + (size_t)row * 32 + 8);
#pragma unroll
        for (int j = 0; j < 4; ++j) { const f32x4 t = lp[j]; lr[4 * j] = t.x; lr[4 * j + 1] = t.y; lr[4 * j + 2] = t.z; lr[4 * j + 3] = t.w; }
#pragma unroll
        for (int e = 0; e < 16; ++e) bc[e] = W2s[2048 + d0 + e];
#pragma unroll
        for (int r = 0; r < 16; ++r) {
#pragma unroll
            for (int e4 = 0; e4 < 4; ++e4) { const f32x4 w = *(const LAS f32x4*)(W2s + r * 128 + d0 + 4 * e4);
                bc[4 * e4] += lr[r] * w.x; bc[4 * e4 + 1] += lr[r] * w.y; bc[4 * e4 + 2] += lr[r] * w.z; bc[4 * e4 + 3] += lr[r] * w.w; }
        }
#pragma unroll
        for (int e = 0; e < 16; ++e) bc[e] = -softplusf_(-bc[e]) * (1.f / 16.f);
    } else {
#pragma unroll
        for (int e = 0; e < 16; ++e) bc[e] = 0.f;
    }
#pragma unroll
    for (int o = 1; o < 64; o <<= 1)
#pragma unroll
        for (int e = 0; e < 16; ++e) { const float t = __shfl_up(bc[e], o); if (lane >= o) bc[e] += t; }
    if (lane == 63) { float* eb = (float*)((unsigned char*)p.out + DS_EBL) + (size_t)item * 128 + d0;
#pragma unroll
        for (int e = 0; e < 16; ++e) eb[e] = __expf(bc[e]); }
    float qv[16], kv[16];
    if (row >= 0) {
        u32x4* qp = (u32x4*)(PA + (size_t)row * LDA_ + 1536 + h * 128 + d0);
        u32x4* kp = (u32x4*)(PA + (size_t)row * LDA_ + 2048 + h * 128 + d0);
        unpack8(qp[0], qv); unpack8(qp[1], qv + 8); unpack8(kp[0], kv); unpack8(kp[1], kv + 8);
#pragma unroll
        for (int e = 0; e < 16; ++e) { qv[e] *= __expf(bc[e]) * 0.08838834764831845f; kv[e] *= __expf(-bc[e]); }
        qp[0] = pack8(qv); qp[1] = pack8(qv + 8); kp[0] = pack8(kv); kp[1] = pack8(kv + 8);
    } else {
#pragma unroll
        for (int e = 0; e < 16; ++e) { qv[e] = 0.f; kv[e] = 0.f; }
    }
    *(LAS u32x4*)(qs + i * SQ + d0) = pack8(qv); *(LAS u32x4*)(qs + i * SQ + d0 + 8) = pack8(qv + 8);
    *(LAS u32x4*)(ks + i * SQ + d0) = pack8(kv); *(LAS u32x4*)(ks + i * SQ + d0 + 8) = pack8(kv + 8);
    __syncthreads();
    bf16_t* ATT = (bf16_t*)((unsigned char*)p.out + DS_ATTB) + (size_t)item * 4096;
    for (int id = wave * 2; id < wave * 2 + 2; ++id) {
        const int ti = id >> 2, tj = id & 3;
        const int ii = 16 * ti + fr, j0 = 16 * tj + 4 * fq;
        if (tj > ti) { *(u32x2*)(ATT + ii * 64 + j0) = (u32x2){0u, 0u}; continue; }
        f32x4 acc = {0.f, 0.f, 0.f, 0.f};
#pragma unroll
        for (int k0 = 0; k0 < 128; k0 += 32) acc = MFMA16(lfrag(ks, 16 * tj + fr, SQ, k0, fq), lfrag(qs, 16 * ti + fr, SQ, k0, fq), acc);
        float o[4];
#pragma unroll
        for (int r = 0; r < 4; ++r) o[r] = (ii >= j0 + r) ? acc[r] : 0.f;
        u32x2 w; w.x = pk2(o[0], o[1]); w.y = pk2(o[2], o[3]); *(u32x2*)(ATT + ii * 64 + j0) = w;
    }
    __syncthreads();
}

__device__ __forceinline__ void p3_decode_delta(const Params& p, LAS unsigned char* lds, int item) {
    const int tid = threadIdx.x, lane = tid & 63, wave = tid >> 6;
    const int n = item >> 2, h = item & 3, row = RDEC0 + n;
    const bf16_t* PA = (const bf16_t*)(p.ws + WS_PROJA);
    const float* SMALL = (const float*)((unsigned char*)p.out + DS_SMALL);
    LAS float* vals = (LAS float*)lds;
    LAS float* part = vals + 384;
    LAS float* red = part + 8;
    float y = 0.f;
    if (tid < 384) {
        const int sel = tid >> 7, chl = tid & 127, ch = sel * 512 + h * 128 + chl;
        const float* st = p.in[I_SDC] + (size_t)n * 3 * CA + ch;
        const float s0 = st[0], s1 = st[CA], s2 = st[2 * CA], xn = bf2f(PA[(size_t)row * LDA_ + ch]);
        const float* wc = p.in[I_WCA] + ch;
        y = siluf_(wc[0] * s0 + wc[CA] * s1 + wc[2 * CA] * s2 + wc[3 * CA] * xn);
        float* o = p.out + O_DCS + (size_t)n * 3 * CA + ch; o[0] = s1; o[CA] = s2; o[2 * CA] = xn;
        vals[tid] = y;
    }
    const float ws_ = wave_sum(y * y);
    if (lane == 0) part[wave] = ws_;
    __syncthreads();
    const float rq = rsqrtf(part[0] + part[1] + EPS) * 0.08838834764831845f, rk = rsqrtf(part[2] + part[3] + EPS);
    const float beta = sigmoidf_(SMALL[(size_t)row * 32 + h]);
    const float eg = __expf(-__expf(p.in[I_ALOG][h]) * softplusf_(SMALL[(size_t)row * 32 + 4 + h] + p.in[I_DTB][h]));
    const int e = tid & 127, kq = tid >> 7;
    const float* Sp = p.in[I_SD] + ((size_t)item * 128 + 32 * kq) * 128 + e;
    float S[32]; float pe = 0.f;
#pragma unroll
    for (int k = 0; k < 32; ++k) { S[k] = Sp[(size_t)k * 128] * eg; pe += vals[128 + 32 * kq + k] * rk * S[k]; }
    red[kq * 128 + e] = pe;
    __syncthreads();
    const float err = (vals[256 + e] - (red[e] + red[128 + e] + red[256 + e] + red[384 + e])) * beta;
    __syncthreads();
    float* So = p.out + O_DS + ((size_t)item * 128 + 32 * kq) * 128 + e; float po = 0.f;
#pragma unroll
    for (int k = 0; k < 32; ++k) { const float s = S[k] + vals[128 + 32 * kq + k] * rk * err; So[(size_t)k * 128] = s; po += vals[32 * kq + k] * rq * s; }
    red[kq * 128 + e] = po;
    __syncthreads();
    if (tid < 128) ((bf16_t*)((unsigned char*)p.out + DS_OA))[(size_t)row * 512 + h * 128 + e] = (bf16_t)f2bf(red[e] + red[128 + e] + red[256 + e] + red[384 + e]);
    __syncthreads();
}
__device__ __forceinline__ void p3_decode_gla(const Params& p, LAS unsigned char* lds, int item) {
    const int tid = threadIdx.x;
    const int n = item >> 2, h = item & 3, row = RDEC0 + n;
    const bf16_t* PA = (const bf16_t*)(p.ws + WS_PROJA);
    const float* SMALL = (const float*)((unsigned char*)p.out + DS_SMALL);
    LAS float* qv = (LAS float*)lds; LAS float* kv = qv + 128; LAS float* dv = kv + 128; LAS float* red = dv + 128;
    if (tid < 128) {
        float x = p.in[I_BGK][h * 128 + tid];
#pragma unroll
        for (int r = 0; r < 16; ++r) x += SMALL[(size_t)row * 32 + 8 + r] * p.in[I_WGK2][r * 512 + h * 128 + tid];
        dv[tid] = __expf(-softplusf_(-x) * (1.f / 16.f));
        qv[tid] = bf2f(PA[(size_t)row * LDA_ + 1536 + h * 128 + tid]) * 0.08838834764831845f;
        kv[tid] = bf2f(PA[(size_t)row * LDA_ + 2048 + h * 128 + tid]);
    }
    __syncthreads();
    const int e = tid & 255, kh = tid >> 8;
    const float ve = bf2f(PA[(size_t)row * LDA_ + 2560 + h * 256 + e]);
    const float* Sp = p.in[I_SG] + ((size_t)item * 128 + 64 * kh) * 256 + e;
    float* So = p.out + O_GS + ((size_t)item * 128 + 64 * kh) * 256 + e;
    float po = 0.f;
#pragma unroll 16
    for (int k = 0; k < 64; ++k) { const int kk = 64 * kh + k; const float s = Sp[(size_t)k * 256] * dv[kk] + kv[kk] * ve; So[(size_t)k * 256] = s; po += qv[kk] * s; }
    red[kh * 256 + e] = po;
    __syncthreads();
    if (tid < 256) ((bf16_t*)(p.ws + WS_OB))[(size_t)row * 1024 + h * 256 + e] = (bf16_t)f2bf(red[e] + red[256 + e]);
    __syncthreads();
}

constexpr int LD_WS = 0, LD_QS = LD_WS + 64 * SQ * 2, LD_AS = LD_QS + 64 * SQ * 2, LD_KT = LD_AS + 64 * SK * 2, LD_US = LD_KT + 128 * SK * 2,
              LD_ST = LD_US + 64 * 40 * 2, LD_VN = LD_ST + 32 * SQ * 2, LD_ENDD = LD_VN + 32 * SK * 2;
static_assert(LD_ENDD <= LDS_BYTES, "delta scan LDS");
__device__ __forceinline__ void p3_scan_delta(const Params& p, LAS unsigned char* lds, int sid) {
    const int tid = threadIdx.x, lane = tid & 63, wave = tid >> 6, fr = lane & 15, fq = lane >> 4;
    const int bh = sid >> 2, sl = sid & 3, h = bh & 3, b = bh >> 2;
    unsigned char* ws = p.ws;
    const bf16_t* QT = (const bf16_t*)(ws + WS_QT); const bf16_t* KT = (const bf16_t*)(ws + WS_KT); const bf16_t* WW = (const bf16_t*)(ws + WS_WW);
    const bf16_t* UU = (const bf16_t*)(ws + WS_UU); const bf16_t* ATT = (const bf16_t*)(ws + WS_ATTA);
    const float* EGL = (const float*)((unsigned char*)p.out + DS_EGL);
    bf16_t* OA = (bf16_t*)((unsigned char*)p.out + DS_OA);
    LAS bf16_t* Wsm = (LAS bf16_t*)(lds + LD_WS); LAS bf16_t* Qsm = (LAS bf16_t*)(lds + LD_QS); LAS bf16_t* Asm = (LAS bf16_t*)(lds + LD_AS);
    LAS bf16_t* KTs = (LAS bf16_t*)(lds + LD_KT); LAS bf16_t* Us = (LAS bf16_t*)(lds + LD_US); LAS bf16_t* St = (LAS bf16_t*)(lds + LD_ST); LAS bf16_t* VnT = (LAS bf16_t*)(lds + LD_VN);
    for (int e = tid; e < 32 * SQ / 2; e += NTHR) ((LAS unsigned*)St)[e] = 0u;
    f32x4 Sacc[2] = {{0.f, 0.f, 0.f, 0.f}, {0.f, 0.f, 0.f, 0.f}};
    const int it = wave >> 1, et = wave & 1;
    u32x4 rw[2], rq_[2], rk_[2], ra, ru;
    const u32x4 zero4 = {0u, 0u, 0u, 0u};
#define DELTA_PREFETCH(cc) do { const int item_ = bh * NCH + (cc); \
        _Pragma("unroll") for (int s = 0; s < 2; ++s) { const int pi = tid + 512 * s, rr = pi >> 4, c8 = pi & 15; const int gr = prow(b, (cc), rr); \
            if (gr >= 0) { const size_t off = (size_t)gr * 512 + h * 128 + 8 * c8; rw[s] = *(const u32x4*)(WW + off); rq_[s] = *(const u32x4*)(QT + off); rk_[s] = *(const u32x4*)(KT + off); } \
            else { rw[s] = zero4; rq_[s] = zero4; rk_[s] = zero4; } } \
        ra = *(const u32x4*)(ATT + (size_t)item_ * 4096 + tid * 8); \
        if (tid < 256) { const int rr = tid >> 2, c8 = tid & 3; const int gr = prow(b, (cc), rr); ru = gr >= 0 ? *(const u32x4*)(UU + (size_t)gr * 512 + h * 128 + 32 * sl + 8 * c8) : zero4; } } while (0)
    DELTA_PREFETCH(0);
    for (int c = 0; c < NCH; ++c) {
        __syncthreads();
#pragma unroll
        for (int s = 0; s < 2; ++s) { const int pi = tid + 512 * s, rr = pi >> 4, c8 = pi & 15;
            *(LAS u32x4*)(Wsm + rr * SQ + 8 * c8) = rw[s]; *(LAS u32x4*)(Qsm + rr * SQ + 8 * c8) = rq_[s];
            const unsigned kk[4] = {rk_[s].x, rk_[s].y, rk_[s].z, rk_[s].w};
#pragma unroll
            for (int e = 0; e < 4; ++e) { KTs[(8 * c8 + 2 * e) * SK + rr] = (bf16_t)(kk[e] & 0xffffu); KTs[(8 * c8 + 2 * e + 1) * SK + rr] = (bf16_t)(kk[e] >> 16); } }
        *(LAS u32x4*)(Asm + (tid >> 3) * SK + (tid & 7) * 8) = ra;
        if (tid < 256) *(LAS u32x4*)(Us + (tid >> 2) * 40 + (tid & 3) * 8) = ru;
        const float egl = EGL[bh * NCH + c];
        if (c + 1 < NCH) DELTA_PREFETCH(c + 1);
        __syncthreads();
        f32x4 av = {0.f, 0.f, 0.f, 0.f}, ao = {0.f, 0.f, 0.f, 0.f};
#pragma unroll
        for (int k0 = 0; k0 < 128; k0 += 32) {
            const bf16x8 sf = lfrag(St, 16 * et + fr, SQ, k0, fq);
            av = MFMA16(lfrag(Wsm, 16 * it + fr, SQ, k0, fq), sf, av);
            ao = MFMA16(sf, lfrag(Qsm, 16 * it + fr, SQ, k0, fq), ao);
        }
        {
            const int ee = 16 * et + fr, i0 = 16 * it + 4 * fq; float vn[4];
#pragma unroll
            for (int r = 0; r < 4; ++r) vn[r] = bf2f(Us[(i0 + r) * 40 + ee]) - av[r];
            u32x2 w; w.x = pk2(vn[0], vn[1]); w.y = pk2(vn[2], vn[3]); *(LAS u32x2*)(VnT + ee * SK + i0) = w;
        }
        __syncthreads();
#pragma unroll
        for (int k0 = 0; k0 < 64; k0 += 32) ao = MFMA16(lfrag(VnT, 16 * et + fr, SK, k0, fq), lfrag(Asm, 16 * it + fr, SK, k0, fq), ao);
        {
            const int gr = prow(b, c, 16 * it + fr);
            if (gr >= 0) { u32x2 w; w.x = pk2(ao[0], ao[1]); w.y = pk2(ao[2], ao[3]); *(u32x2*)(OA + (size_t)gr * 512 + h * 128 + 32 * sl + 16 * et + 4 * fq) = w; }
        }
#pragma unroll
        for (int t = 0; t < 2; ++t) {
            f32x4 s = Sacc[t] * egl;
#pragma unroll
            for (int k0 = 0; k0 < 64; k0 += 32) s = MFMA16(lfrag(KTs, 16 * wave + fr, SK, k0, fq), lfrag(VnT, 16 * t + fr, SK, k0, fq), s);
            Sacc[t] = s;
            u32x2 w; w.x = pk2(s[0], s[1]); w.y = pk2(s[2], s[3]); *(LAS u32x2*)(St + (16 * t + fr) * SQ + 16 * wave + 4 * fq) = w;
        }
    }
#undef DELTA_PREFETCH
#pragma unroll
    for (int t = 0; t < 2; ++t)
#pragma unroll
        for (int r = 0; r < 4; ++r) p.out[O_DP + ((size_t)bh * 128 + 16 * wave + 4 * fq + r) * 128 + 32 * sl + 16 * t + fr] = Sacc[t][r];
    __syncthreads();
}

constexpr int LG_QS = 0, LG_KT = LG_QS + 64 * SQ * 2, LG_AS = LG_KT + 128 * SK * 2, LG_VT = LG_AS + 64 * SK * 2, LG_ST = LG_VT + 64 * SK * 2, LG_END = LG_ST + 64 * SQ * 2;
static_assert(LG_END <= LDS_BYTES, "gla scan LDS");
__device__ __forceinline__ void p3_scan_gla(const Params& p, LAS unsigned char* lds, int sid) {
    const int tid = threadIdx.x, lane = tid & 63, wave = tid >> 6, fr = lane & 15, fq = lane >> 4;
    const int bh = sid >> 2, sl = sid & 3, h = bh & 3, b = bh >> 2;
    unsigned char* ws = p.ws;
    const bf16_t* PA = (const bf16_t*)(ws + WS_PROJA);
    const bf16_t* ATT = (const bf16_t*)((unsigned char*)p.out + DS_ATTB);
    const float* EBL = (const float*)((unsigned char*)p.out + DS_EBL);
    bf16_t* OB = (bf16_t*)(ws + WS_OB);
    LAS bf16_t* Qsm = (LAS bf16_t*)(lds + LG_QS); LAS bf16_t* KTs = (LAS bf16_t*)(lds + LG_KT); LAS bf16_t* Asm = (LAS bf16_t*)(lds + LG_AS);
    LAS bf16_t* VT = (LAS bf16_t*)(lds + LG_VT); LAS bf16_t* St = (LAS bf16_t*)(lds + LG_ST);
    for (int e = tid; e < 64 * SQ / 2; e += NTHR) ((LAS unsigned*)St)[e] = 0u;
    f32x4 Sacc[4];
#pragma unroll
    for (int t = 0; t < 4; ++t) Sacc[t] = (f32x4){0.f, 0.f, 0.f, 0.f};
    const int it = wave >> 1, eh = wave & 1;
    u32x4 rq_[2], rk_[2], ra, rv;
    const u32x4 zero4 = {0u, 0u, 0u, 0u};
#define GLA_PREFETCH(cc) do { const int item_ = bh * NCH + (cc); \
        _Pragma("unroll") for (int s = 0; s < 2; ++s) { const int pi = tid + 512 * s, rr = pi >> 4, c8 = pi & 15; const int gr = prow(b, (cc), rr); \
            if (gr >= 0) { const size_t off = (size_t)gr * LDA_ + h * 128 + 8 * c8; rq_[s] = *(const u32x4*)(PA + off + 1536); rk_[s] = *(const u32x4*)(PA + off + 2048); } \
            else { rq_[s] = zero4; rk_[s] = zero4; } } \
        ra = *(const u32x4*)(ATT + (size_t)item_ * 4096 + tid * 8); \
        { const int rr = tid >> 3, c8 = tid & 7; const int gr = prow(b, (cc), rr); rv = gr >= 0 ? *(const u32x4*)(PA + (size_t)gr * LDA_ + 2560 + h * 256 + 64 * sl + 8 * c8) : zero4; } } while (0)
    GLA_PREFETCH(0);
    for (int c = 0; c < NCH; ++c) {
        __syncthreads();
#pragma unroll
        for (int s = 0; s < 2; ++s) { const int pi = tid + 512 * s, rr = pi >> 4, c8 = pi & 15;
            *(LAS u32x4*)(Qsm + rr * SQ + 8 * c8) = rq_[s];
            const unsigned kk[4] = {rk_[s].x, rk_[s].y, rk_[s].z, rk_[s].w};
#pragma unroll
            for (int e = 0; e < 4; ++e) { KTs[(8 * c8 + 2 * e) * SK + rr] = (bf16_t)(kk[e] & 0xffffu); KTs[(8 * c8 + 2 * e + 1) * SK + rr] = (bf16_t)(kk[e] >> 16); } }
        *(LAS u32x4*)(Asm + (tid >> 3) * SK + (tid & 7) * 8) = ra;
        { const int rr = tid >> 3, c8 = tid & 7; const unsigned vv[4] = {rv.x, rv.y, rv.z, rv.w};
#pragma unroll
            for (int e = 0; e < 4; ++e) { VT[(8 * c8 + 2 * e) * SK + rr] = (bf16_t)(vv[e] & 0xffffu); VT[(8 * c8 + 2 * e + 1) * SK + rr] = (bf16_t)(vv[e] >> 16); } }
        f32x4 dd = *(const f32x4*)(EBL + (size_t)(bh * NCH + c) * 128 + 16 * wave + 4 * fq);
        if (c + 1 < NCH) GLA_PREFETCH(c + 1);
        __syncthreads();
        const int gr = prow(b, c, 16 * it + fr);
#pragma unroll
        for (int t = 0; t < 2; ++t) {
            const int et = 2 * eh + t;
            f32x4 ao = {0.f, 0.f, 0.f, 0.f};
#pragma unroll
            for (int k0 = 0; k0 < 128; k0 += 32) ao = MFMA16(lfrag(St, 16 * et + fr, SQ, k0, fq), lfrag(Qsm, 16 * it + fr, SQ, k0, fq), ao);
#pragma unroll
            for (int k0 = 0; k0 < 64; k0 += 32) ao = MFMA16(lfrag(VT, 16 * et + fr, SK, k0, fq), lfrag(Asm, 16 * it + fr, SK, k0, fq), ao);
            if (gr >= 0) { u32x2 w; w.x = pk2(ao[0], ao[1]); w.y = pk2(ao[2], ao[3]); *(u32x2*)(OB + (size_t)gr * 1024 + h * 256 + 64 * sl + 16 * et + 4 * fq) = w; }
        }
#pragma unroll
        for (int t = 0; t < 4; ++t) {
            f32x4 s = Sacc[t];
#pragma unroll
            for (int k0 = 0; k0 < 64; k0 += 32) s = MFMA16(lfrag(KTs, 16 * wave + fr, SK, k0, fq), lfrag(VT, 16 * t + fr, SK, k0, fq), s);
            Sacc[t] = s * dd;
        }
        __syncthreads();
#pragma unroll
        for (int t = 0; t < 4; ++t) { u32x2 w; w.x = pk2(Sacc[t][0], Sacc[t][1]); w.y = pk2(Sacc[t][2], Sacc[t][3]); *(LAS u32x2*)(St + (16 * t + fr) * SQ + 16 * wave + 4 * fq) = w; }
    }
#undef GLA_PREFETCH
#pragma unroll
    for (int t = 0; t < 4; ++t)
#pragma unroll
        for (int r = 0; r < 4; ++r) p.out[O_GP + ((size_t)bh * 128 + 16 * wave + 4 * fq + r) * 256 + 64 * sl + 16 * t + fr] = Sacc[t][r];
    __syncthreads();
}

__device__ __forceinline__ void p_gate(const Params& p) {
    const int tid = threadIdx.x, lane = tid & 63, wave = tid >> 6;
    const int gw = blockIdx.x * 8 + wave, NGW = gridDim.x * 8;
    bf16_t* OA = (bf16_t*)((unsigned char*)p.out + DS_OA); bf16_t* OB = (bf16_t*)(p.ws + WS_OB); const bf16_t* Z = (const bf16_t*)(p.ws + WS_Z);
    for (int row = gw; row < R; row += NGW) {
        {
            u32x4* op = (u32x4*)(OA + (size_t)row * 512 + 8 * lane); float o[8], z[8]; unpack8(*op, o); unpack8(*(const u32x4*)(Z + (size_t)row * 1536 + 8 * lane), z);
            float s = 0.f;
#pragma unroll
            for (int e = 0; e < 8; ++e) s += o[e] * o[e];
            s += __shfl_xor(s, 1); s += __shfl_xor(s, 2); s += __shfl_xor(s, 4); s += __shfl_xor(s, 8);
            const float rs = rsqrtf(s * (1.f / 128.f) + EPS); const float* nw = p.in[I_ONA] + 8 * (lane & 15);
#pragma unroll
            for (int e = 0; e < 8; ++e) o[e] = o[e] * rs * nw[e] * siluf_(z[e]);
            *op = pack8(o);
        }
        {
            u32x4* op = (u32x4*)(OB + (size_t)row * 1024 + 16 * lane); const u32x4* zp = (const u32x4*)(Z + (size_t)row * 1536 + 512 + 16 * lane);
            float o[16], z[16]; unpack8(op[0], o); unpack8(op[1], o + 8); unpack8(zp[0], z); unpack8(zp[1], z + 8);
            float s = 0.f;
#pragma unroll
            for (int e = 0; e < 16; ++e) s += o[e] * o[e];
            s += __shfl_xor(s, 1); s += __shfl_xor(s, 2); s += __shfl_xor(s, 4); s += __shfl_xor(s, 8);
            const float rs = rsqrtf(s * (1.f / 256.f) + EPS); const float* nw = p.in[I_ONB] + 16 * (lane & 15);
#pragma unroll
            for (int e = 0; e < 16; ++e) o[e] = o[e] * rs * nw[e] * siluf_(z[e]);
            op[0] = pack8(o); op[1] = pack8(o + 8);
        }
    }
}
__device__ __forceinline__ void p_act(const Params& p) {
    const bf16_t* U = (const bf16_t*)(p.ws + WS_U); bf16_t* GF = (bf16_t*)(p.ws + WS_GF);
    const float* wf = p.in[I_WCF]; const float* bfc = p.in[I_BCF];
    const int gt = blockIdx.x * NTHR + threadIdx.x, NGT = gridDim.x * NTHR;
    constexpr int NC8 = DFF / 8, NSTRIP = RP / 16;
    for (int wi = gt; wi < (NSTRIP + NDEC) * NC8; wi += NGT) {
        const int c8 = wi % NC8, st = wi / NC8, col = 8 * c8;
        float w0[8], w1[8], w2[8], bb[8];
#pragma unroll
        for (int e = 0; e < 8; ++e) { w0[e] = wf[col + e]; w1[e] = wf[DFF + col + e]; w2[e] = wf[2 * DFF + col + e]; bb[e] = bfc[col + e]; }
        if (st < NSTRIP) {
            const int r0 = st * 16; float p2[8], p1[8];
            int ra = -1, rb = -1;
            if (r0 < RMAIN) { if ((r0 & (SEQ - 1)) == 0) { const int b = r0 / SEQ; ra = RMETA0 + b * 16 + 14; rb = ra + 1; } else { ra = r0 - 2; rb = r0 - 1; } }
            if (ra >= 0) { unpack8(*(const u32x4*)(U + (size_t)ra * DFF + col), p2); unpack8(*(const u32x4*)(U + (size_t)rb * DFF + col), p1); }
            else {
#pragma unroll
                for (int e = 0; e < 8; ++e) { p2[e] = 0.f; p1[e] = 0.f; } }
            for (int rr = 0; rr < 16; ++rr) {
                const int row = r0 + rr; float u[8], g[8], o[8];
                unpack8(*(const u32x4*)(U + (size_t)row * DFF + col), u); unpack8(*(const u32x4*)(GF + (size_t)row * DFF + col), g);
#pragma unroll
                for (int e = 0; e < 8; ++e) { o[e] = gelu_tanh(w0[e] * p2[e] + w1[e] * p1[e] + w2[e] * u[e] + bb[e]) * g[e]; p2[e] = p1[e]; p1[e] = u[e]; }
                *(u32x4*)(GF + (size_t)row * DFF + col) = pack8(o);
                if (row < RMAIN && (row & (SEQ - 1)) >= SEQ - 2) { float* so = p.out + O_FCP + ((size_t)(row / SEQ) * 2 + ((row & (SEQ - 1)) - (SEQ - 2))) * DFF + col;
#pragma unroll
                    for (int e = 0; e < 8; ++e) so[e] = u[e]; }
            }
        } else {
            const int n = st - NSTRIP, row = RDEC0 + n; float u[8], g[8], o[8];
            const float* s0 = p.in[I_SFC] + (size_t)n * 2 * DFF + col; const float* s1 = s0 + DFF;
            unpack8(*(const u32x4*)(U + (size_t)row * DFF + col), u); unpack8(*(const u32x4*)(GF + (size_t)row * DFF + col), g);
            float* so = p.out + O_FCS + (size_t)n * 2 * DFF + col;
#pragma unroll
            for (int e = 0; e < 8; ++e) { o[e] = gelu_tanh(w0[e] * s0[e] + w1[e] * s1[e] + w2[e] * u[e] + bb[e]) * g[e]; so[e] = s1[e]; so[DFF + e] = u[e]; }
            *(u32x4*)(GF + (size_t)row * DFF + col) = pack8(o);
        }
    }
}
__device__ __forceinline__ void p_final(const Params& p) {
    const float* SS3 = (const float*)(p.ws + WS_SS3); const float* nw = p.in[I_NFIN];
    const int gt = blockIdx.x * NTHR + threadIdx.x, NGT = gridDim.x * NTHR;
    for (int wi = gt; wi < (RMAIN + NDEC) * 256; wi += NGT) {
        const int c4 = wi & 255; int row = wi >> 8; if (row >= RMAIN) row += (RDEC0 - RMAIN);
        const float rs = rsqrtf(SS3[row] * (1.f / D) + EPS);
        f32x4* o = (f32x4*)(p.out + yslot(row)) + c4; const f32x4 w = ((const f32x4*)nw)[c4]; f32x4 v = *o;
        v.x *= rs * w.x; v.y *= rs * w.y; v.z *= rs * w.z; v.w *= rs * w.w; *o = v;
    }
}

constexpr int NPHASE = 12;
__global__ void __launch_bounds__(NTHR, 2) fwd_kernel(Params p) {
    extern __shared__ __attribute__((aligned(16))) unsigned char lds_raw[];
    LAS unsigned char* lds = (LAS unsigned char*)lds_raw;
    cg::grid_group grid = cg::this_grid();
    unsigned char* ws = p.ws; unsigned char* ob = (unsigned char*)p.out;
    const int lo = p.ph_lo, hi = p.ph_hi, G = gridDim.x;
#define IN(k) (lo <= (k) && (k) < hi)
#define SEAM(k) do { if (IN(k) && IN((k) + 1)) grid.sync(); } while (0)
    if (IN(0)) { p0_prologue(p, lds); }
    SEAM(0);
    if (IN(1)) {
        pg8::Gemm g{(const bf16_t*)(ob + DS_HN), (const bf16_t*)(ws + WS_WTA), R, NA, 1024}; pg8::StaticOrder S; S.init(R, NA, G, (int)blockIdx.x);
        pg8::Epi8<FA> E{FA{(bf16_t*)(ws + WS_PROJA), (float*)(ob + DS_SMALL)}};
        pg8::gemm_phase<pg8::Epi8<FA>, pg8::StaticOrder, true, true>(lds, g, S, E);
    }
    SEAM(1);
    if (IN(2)) {
        for (int it = blockIdx.x; it < 2 * NITEM; it += G) { if (it < NITEM) p2_delta_item(p, lds, it); else p2_gla_item(p, lds, it - NITEM); }
    }
    SEAM(2);
    if (IN(3)) {
        for (int it = blockIdx.x; it < NDEC * 4; it += G) p3_decode_delta(p, lds, it);
        for (int it = blockIdx.x; it < NDEC * 4; it += G) p3_decode_gla(p, lds, it);
        const int vb = (G % 8 == 0) ? (int)(blockIdx.x % 8) * (G / 8) + (int)blockIdx.x / 8 : (int)blockIdx.x;
        for (int sid = vb; sid < 256; sid += G) { if (sid < 128) p3_scan_delta(p, lds, sid); else p3_scan_gla(p, lds, sid - 128); }
    }
    SEAM(3);
    if (IN(4)) {
        pg8::Gemm g{(const bf16_t*)(ob + DS_HN), (const bf16_t*)(ws + WS_WTB), R, NBW, 1024}; pg8::StaticOrder S; S.init(R, NBW, G, (int)blockIdx.x);
        pg8::Epi8<FB> E{FB{(bf16_t*)(ws + WS_Z), (bf16_t*)(ws + WS_SG)}};
        pg8::gemm_phase<pg8::Epi8<FB>, pg8::StaticOrder, true, true>(lds, g, S, E);
    }
    SEAM(4);
    if (IN(5)) { p_gate(p); }
    SEAM(5);
    if (IN(6)) {
        {
            pg8::Gemm g{(const bf16_t*)(ob + DS_OA), (const bf16_t*)(ws + WS_WA), RMAIN, 1024, 512}; pg8::StaticOrder S; S.init(RMAIN, 1024, G, (int)blockIdx.x);
            FMix<0> f{(const bf16_t*)(ws + WS_SG), (bf16_t*)(ws + WS_MIX)}; pg8::Epi8<FMix<0>> E{f};
            pg8::gemm_phase<pg8::Epi8<FMix<0>>, pg8::StaticOrder, true, true>(lds, g, S, E);
            thin_gemm(lds, g.A, g.Bt, 512, 1024, RMAIN, f);
        }
        {
            pg8::Gemm g{(const bf16_t*)(ws + WS_OB), (const bf16_t*)(ws + WS_WB), RMAIN, 1024, 1024}; pg8::StaticOrder S; S.init(RMAIN, 1024, G, (int)blockIdx.x);
            FMix<1> f{(const bf16_t*)(ws + WS_SG), (bf16_t*)(ws + WS_MIX)}; pg8::Epi8<FMix<1>> E{f};
            pg8::gemm_phase<pg8::Epi8<FMix<1>>, pg8::StaticOrder, true, true>(lds, g, S, E);
            thin_gemm(lds, g.A, g.Bt, 1024, 1024, RMAIN, f);
        }
    }
    SEAM(6);
    if (IN(7)) {
        pg8::Gemm g{(const bf16_t*)(ws + WS_MIX), (const bf16_t*)(ws + WS_WO), RMAIN, 1024, 1024}; pg8::StaticOrder S; S.init(RMAIN, 1024, G, (int)blockIdx.x);
        FX2 f{p.in[I_XP], p.in[I_META], p.in[I_XS], p.out, p.in[I_NFFN], (bf16_t*)(ws + WS_HN2), (float*)(ws + WS_SS2)}; pg8::Epi8<FX2> E{f};
        pg8::gemm_phase<pg8::Epi8<FX2>, pg8::StaticOrder, true, true>(lds, g, S, E);
        thin_gemm(lds, g.A, g.Bt, 1024, 1024, RMAIN, f);
    }
    SEAM(7);
    if (IN(8)) {
        pg8::Gemm g{(const bf16_t*)(ws + WS_HN2), (const bf16_t*)(ws + WS_WF1), R, 5632, 1024}; pg8::StaticOrder S; S.init(R, 5632, G, (int)blockIdx.x);
        pg8::Epi8<FF1> E{FF1{(const float*)(ws + WS_SS2), (bf16_t*)(ws + WS_U), (bf16_t*)(ws + WS_GF)}};
        pg8::gemm_phase<pg8::Epi8<FF1>, pg8::StaticOrder, true, true>(lds, g, S, E);
    }
    SEAM(8);
    if (IN(9)) { p_act(p); }
    SEAM(9);
    if (IN(10)) {
        pg8::Gemm g{(const bf16_t*)(ws + WS_GF), (const bf16_t*)(ws + WS_WF2), RMAIN, 1024, DFF}; pg8::StaticOrder S; S.init(RMAIN, 1024, G, (int)blockIdx.x);
        FF2 f{p.out, (float*)(ws + WS_SS3)}; pg8::Epi8<FF2> E{f};
        pg8::gemm_phase<pg8::Epi8<FF2>, pg8::StaticOrder, true, true>(lds, g, S, E);
        thin_gemm(lds, g.A, g.Bt, DFF, 1024, RMAIN, f);
    }
    SEAM(10);
    if (IN(11)) { p_final(p); }
#undef IN
#undef SEAM
}

#ifndef N_LAUNCH_MODE
#define N_LAUNCH_MODE 1
#endif
extern "C" void kernel_launch(void* const* d_in, const int* in_sizes, int n_in, void* d_out, int out_size, void* d_ws, size_t ws_size, hipStream_t stream) {
    static int grid = 0;
    if (grid == 0) {
        int dev = 0, cus = 0, per_cu = 0;
        hipGetDevice(&dev); hipDeviceGetAttribute(&cus, hipDeviceAttributeMultiprocessorCount, dev);
        hipFuncSetAttribute((const void*)fwd_kernel, hipFuncAttributeMaxDynamicSharedMemorySize, LDS_BYTES);
        hipOccupancyMaxActiveBlocksPerMultiprocessor(&per_cu, (const void*)fwd_kernel, NTHR, LDS_BYTES);
        if (per_cu < 1) { fprintf(stderr, "occupancy query says %d blocks/CU\n", per_cu); per_cu = 1; }
        grid = cus * 1;
        if (n_in != 25 || (size_t)out_size != O_END || ws_size < 256 * MiB) fprintf(stderr, "kernel_launch: unexpected sizes n_in %d out %d ws %zu\n", n_in, out_size, ws_size);
    }
    Params p{};
    for (int i = 0; i < 25; ++i) p.in[i] = (const float*)d_in[i];
    p.out = (float*)d_out; p.ws = (unsigned char*)d_ws;
#if N_LAUNCH_MODE == 1
    p.ph_lo = 0; p.ph_hi = NPHASE;
    void* args[] = {&p};
    hipError_t e = hipLaunchCooperativeKernel((const void*)fwd_kernel, dim3(grid), dim3(NTHR), args, LDS_BYTES, stream);
    if (e != hipSuccess) fprintf(stderr, "cooperative launch failed: %s (grid %d)\n", hipGetErrorString(e), grid);
#else
    for (int k = 0; k < NPHASE; ++k) { p.ph_lo = k; p.ph_hi = k + 1; hipLaunchKernelGGL(fwd_kernel, dim3(grid), dim3(NTHR), LDS_BYTES, stream, p); }
#endif
}
```

```cpp
#include <hip/hip_runtime.h>
#include <hip/hip_cooperative_groups.h>
#include <cstdio>
#include <cstdint>
namespace cg = cooperative_groups;
namespace pg8 {
#define PG8_LAS __attribute__((address_space(3)))
typedef unsigned short bf16_t;
typedef short bf16x8 __attribute__((ext_vector_type(8)));
typedef float f32x4 __attribute__((ext_vector_type(4)));
typedef unsigned u32x4 __attribute__((ext_vector_type(4)));
constexpr int BM = 256, BK = 64, HALF = 128, HTB = HALF * BK * 2  , STAGE_BYTES = 8 * HTB, NXCD = 8, WGM = 8;

__host__ __device__ __forceinline__ int lds_byte(int r, int c) { const int st = (r >> 4) * 2 + (c >> 5), rr = r & 15, cc = c & 31, ob = rr * 64 + cc * 2; return st * 1024 + (ob ^ (((ob >> 9) & 1) << 5)); }
__host__ __device__ __forceinline__ void stage_rc(int b, int& R, int& C) { const int st = b / 1024, sb = b % 1024, swz = sb ^ (((sb >> 9) & 1) << 5); R = (st >> 1) * 16 + swz / 64; C = (st & 1) * 32 + (swz % 64) / 2; }
__host__ __device__ __forceinline__ int perm32(int rho) { const int n = rho >> 4, i = rho & 15; return 8 * (i >> 2) + 4 * n + (i & 3); }

struct Unit { int pm, pn; };
struct Gemm { const bf16_t* A; const bf16_t* Bt; int M, N, K; };

struct StaticOrder {
    int nM, nN, nwg, G, c;
    __host__ __device__ void init(int M, int N, int G_, int c_) { nM = M / BM; nN = N / BM; nwg = nM * nN; G = G_; c = c_; }
    __host__ __device__ bool next(int i, Unit& u) const {
        const long L = (long)i * G + c; if (L >= nwg) return false;
        int wgid = (int)L; { const int q = nwg / NXCD, r = nwg % NXCD, xcd = wgid % NXCD, off = wgid / NXCD; wgid = (xcd < r ? xcd * (q + 1) : r * (q + 1) + (xcd - r) * q) + off; }
        const int nig = WGM * nN, gid = wgid / nig, fm = gid * WGM, gsz = (nM - fm) < WGM ? (nM - fm) : WGM;
        u.pm = fm + ((wgid % nig) % gsz); u.pn = (wgid % nig) / gsz; return true;
    }
    __device__ __forceinline__ void a_ready(const Unit&) const {}
    __device__ __forceinline__ void done(const Unit&) const {}
};

template <class F> struct Epi8 {
    static constexpr bool PERM = true, AFTER_DRAIN = false;
    F f;
    __device__ __forceinline__ void operator()(const f32x4 (&acc)[2][2][4][2], const Unit& u, int wr, int wc, int fr, int fq) const {
#pragma unroll
        for (int ai = 0; ai < 2; ++ai)
#pragma unroll
            for (int mp = 0; mp < 4; mp += F::MB) {
                typename F::Pre pre[F::MB][2];
#pragma unroll
                for (int m = 0; m < F::MB; ++m)
#pragma unroll
                    for (int bj = 0; bj < 2; ++bj) pre[m][bj] = f.pre(u.pm * BM + ai * HALF + wr * 64 + (mp + m) * 16 + fr, u.pn * BM + bj * HALF + wc * 32 + 8 * fq);
#pragma unroll
                for (int m = 0; m < F::MB; ++m) {
                    const int row = u.pm * BM + ai * HALF + wr * 64 + (mp + m) * 16 + fr;
                    float ss = 0.f;
#pragma unroll
                    for (int bj = 0; bj < 2; ++bj) { const int col = u.pn * BM + bj * HALF + wc * 32 + 8 * fq; ss += f(row, col, acc[ai][bj][mp + m][0], acc[ai][bj][mp + m][1], pre[m][bj]); }
                    if (F::HAS_SS) { ss += __shfl_xor(ss, 16); ss += __shfl_xor(ss, 32); if (fq == 0) f.add_ss(row, ss); }
                }
            }
    }
};
template <class Epi, class Sched, bool ALIGN_EPI = false, bool SP2 = false>
__device__ __forceinline__ void gemm_phase(PG8_LAS unsigned char* lds, const Gemm g, const Sched& S, const Epi& E) {
    const int tid = threadIdx.x, wid = __builtin_amdgcn_readfirstlane(tid >> 6), lane = tid & 63, wr = wid >> 2, wc = wid & 3, fr = lane & 15, fq = lane >> 4;
    const int K = g.K, nt = K / BK;
    unsigned voffA[2], voffB[2];
#pragma unroll
    for (int i = 0; i < 2; ++i) { int R, C; stage_rc(tid * 16 + i * 8192, R, C); const int Rb = Epi::PERM ? ((R & ~31) + perm32(R & 31)) : R;
        voffA[i] = (unsigned)(R * K + C) * 2u; voffB[i] = (unsigned)(Rb * K + C) * 2u; }
    const size_t kstep = (size_t)(BK * 2);
    const size_t hstep = (size_t)HALF * K * 2;
    const size_t tstep = 2 * hstep;
    const unsigned ldsw = (unsigned)wid * 1024u;
    const int aoff = lds_byte(wr * 64 + fr, fq * 8), boff = lds_byte(wc * 32 + fr, fq * 8);
#define PG8_SA(b, h) (((b) * 2 + (h)) * HTB)
#define PG8_SB(b, h) ((4 + (b) * 2 + (h)) * HTB)
#define PG8_STAGE(bufoff, gbase, voff) do { _Pragma("unroll") for (int _i = 0; _i < 2; ++_i) \
        __builtin_amdgcn_global_load_lds((const unsigned*)((const char*)(gbase) + (voff)[_i]), (PG8_LAS unsigned*)(lds + (bufoff) + ldsw + _i * 8192), 16, 0, 0); } while (0)
#define PG8_LDA(dst, b, h) do { _Pragma("unroll") for (int m = 0; m < 4; ++m) _Pragma("unroll") for (int k = 0; k < 2; ++k) dst[m][k] = *(const PG8_LAS bf16x8*)(lds + PG8_SA(b, h) + aoff + m * 2048 + k * 1024); } while (0)
#define PG8_LDB(dst, b, h) do { _Pragma("unroll") for (int n = 0; n < 2; ++n) _Pragma("unroll") for (int k = 0; k < 2; ++k) dst[n][k] = *(const PG8_LAS bf16x8*)(lds + PG8_SB(b, h) + boff + n * 2048 + k * 1024); } while (0)
#define PG8_MMA(ai, bj, At, Bt) do { __builtin_amdgcn_s_setprio(1); _Pragma("unroll") for (int m = 0; m < 4; ++m) _Pragma("unroll") for (int n = 0; n < 2; ++n) _Pragma("unroll") for (int k = 0; k < 2; ++k) \
        acc[ai][bj][m][n] = __builtin_amdgcn_mfma_f32_16x16x32_bf16(Bt[n][k], At[m][k], acc[ai][bj][m][n], 0, 0, 0); __builtin_amdgcn_s_setprio(0); } while (0)
#define PG8_WAIT_V(n) asm volatile("s_waitcnt vmcnt(" #n ")" ::: "memory")
#define PG8_WAIT_L(n) asm volatile("s_waitcnt lgkmcnt(" #n ")" ::: "memory")
#define PG8_BAR __builtin_amdgcn_s_barrier()
#define PG8_SCHED __builtin_amdgcn_sched_barrier(0)
    Unit cur, nxt; int ui = 0;
    if (!S.next(0, cur)) return;
    f32x4 acc[2][2][4][2];
#pragma unroll
    for (int a = 0; a < 2; ++a)
#pragma unroll
        for (int b = 0; b < 2; ++b)
#pragma unroll
            for (int m = 0; m < 4; ++m)
#pragma unroll
                for (int n = 0; n < 2; ++n) acc[a][b][m][n] = (f32x4){0.f, 0.f, 0.f, 0.f};
    bf16x8 At[4][2], B0[2][2], B1[2][2];
    const char* cA = (const char*)g.A + (size_t)cur.pm * tstep; const char* cB = (const char*)g.Bt + (size_t)cur.pn * tstep;
    S.a_ready(cur);
    if constexpr (SP2) {
        PG8_STAGE(PG8_SB(0, 0), cB, voffB); PG8_STAGE(PG8_SB(0, 1), cB + hstep, voffB); PG8_STAGE(PG8_SA(0, 0), cA, voffA); PG8_STAGE(PG8_SA(0, 1), cA + hstep, voffA);
        if (wr == 1) PG8_BAR;
        PG8_WAIT_V(2); PG8_BAR;
        PG8_STAGE(PG8_SB(1, 0), cB + kstep, voffB); PG8_STAGE(PG8_SA(1, 0), cA + kstep, voffA); PG8_STAGE(PG8_SB(1, 1), cB + hstep + kstep, voffB);
        PG8_WAIT_V(6); PG8_BAR;
    } else {
        PG8_STAGE(PG8_SB(0, 0), cB, voffB); PG8_STAGE(PG8_SA(0, 0), cA, voffA); PG8_STAGE(PG8_SB(0, 1), cB + hstep, voffB); PG8_STAGE(PG8_SA(0, 1), cA + hstep, voffA);
        if (wr == 1) PG8_BAR;
        PG8_WAIT_V(4); PG8_BAR;
        PG8_STAGE(PG8_SB(1, 0), cB + kstep, voffB); PG8_STAGE(PG8_SA(1, 0), cA + kstep, voffA); PG8_STAGE(PG8_SB(1, 1), cB + hstep + kstep, voffB);
        PG8_WAIT_V(6); PG8_BAR;
    }
    for (;;) {
        const bool has_next = S.next(ui + 1, nxt);
        const char* nA = has_next ? (const char*)g.A + (size_t)nxt.pm * tstep : cA; const char* nB = has_next ? (const char*)g.Bt + (size_t)nxt.pn * tstep : cB;
        for (int t = 0; t < nt; t += 2) {
            const bool last = (t == nt - 2);
            const char* a1 = cA + (size_t)(t + 1) * kstep;
            const char* a2 = last ? nA : cA + (size_t)(t + 2) * kstep; const char* b2 = last ? nB : cB + (size_t)(t + 2) * kstep;
            const char* a3 = a2 + kstep; const char* b3 = b2 + kstep;
            if (last && has_next) S.a_ready(nxt);
            if constexpr (SP2) {
            PG8_LDB(B0, 0, 0); PG8_LDB(B1, 0, 1); PG8_SCHED; PG8_LDA(At, 0, 0); PG8_STAGE(PG8_SA(1, 1), a1 + hstep, voffA);
            PG8_WAIT_V(8); PG8_WAIT_L(0); PG8_BAR; PG8_MMA(0, 0, At, B0); PG8_MMA(0, 1, At, B1); PG8_BAR; PG8_SCHED;
            PG8_LDA(At, 0, 1); PG8_STAGE(PG8_SB(0, 0), b2, voffB); PG8_STAGE(PG8_SB(0, 1), b2 + hstep, voffB); PG8_STAGE(PG8_SA(0, 0), a2, voffA);
            PG8_WAIT_V(8); PG8_WAIT_L(0); PG8_BAR; PG8_MMA(1, 0, At, B0); PG8_MMA(1, 1, At, B1); PG8_BAR; PG8_SCHED;
            PG8_LDB(B0, 1, 0); PG8_LDB(B1, 1, 1); PG8_SCHED; PG8_LDA(At, 1, 0); PG8_STAGE(PG8_SA(0, 1), a2 + hstep, voffA);
            PG8_WAIT_V(8); PG8_WAIT_L(0); PG8_BAR; PG8_MMA(0, 0, At, B0); PG8_MMA(0, 1, At, B1); PG8_BAR; PG8_SCHED;
            PG8_LDA(At, 1, 1); PG8_STAGE(PG8_SB(1, 0), b3, voffB); PG8_STAGE(PG8_SB(1, 1), b3 + hstep, voffB); PG8_STAGE(PG8_SA(1, 0), a3, voffA);
            PG8_WAIT_V(8); PG8_WAIT_L(0); PG8_BAR; PG8_MMA(1, 0, At, B0); PG8_MMA(1, 1, At, B1); PG8_BAR; PG8_SCHED;
            } else {
            PG8_LDB(B0, 0, 0); PG8_SCHED; PG8_LDA(At, 0, 0); PG8_STAGE(PG8_SA(1, 1), a1 + hstep, voffA);
            PG8_WAIT_L(8); PG8_BAR; PG8_WAIT_L(0); PG8_MMA(0, 0, At, B0); PG8_BAR; PG8_SCHED;
            PG8_LDB(B1, 0, 1); PG8_STAGE(PG8_SB(0, 0), b2, voffB);
            PG8_BAR; PG8_WAIT_L(0); PG8_MMA(0, 1, At, B1); PG8_BAR;
            PG8_LDA(At, 0, 1); PG8_STAGE(PG8_SA(0, 0), a2, voffA);
            PG8_BAR; PG8_WAIT_L(0); PG8_MMA(1, 0, At, B0); PG8_BAR; PG8_SCHED;
            PG8_STAGE(PG8_SB(0, 1), b2 + hstep, voffB);
            PG8_WAIT_V(6); PG8_BAR; PG8_MMA(1, 1, At, B1); PG8_BAR;
            PG8_LDB(B0, 1, 0); PG8_SCHED; PG8_LDA(At, 1, 0); PG8_STAGE(PG8_SA(0, 1), a2 + hstep, voffA);
            PG8_WAIT_L(8); PG8_BAR; PG8_WAIT_L(0); PG8_MMA(0, 0, At, B0); PG8_BAR; PG8_SCHED;
            PG8_LDB(B1, 1, 1); PG8_STAGE(PG8_SB(1, 0), b3, voffB);
            PG8_BAR; PG8_WAIT_L(0); PG8_MMA(0, 1, At, B1); PG8_BAR;
            PG8_LDA(At, 1, 1); PG8_STAGE(PG8_SA(1, 0), a3, voffA);
            PG8_BAR; PG8_WAIT_L(0); PG8_MMA(1, 0, At, B0); PG8_BAR; PG8_SCHED;
            PG8_STAGE(PG8_SB(1, 1), b3 + hstep, voffB);
            PG8_WAIT_V(6); PG8_BAR; PG8_MMA(1, 1, At, B1); PG8_BAR;
            }
        }
        if constexpr (ALIGN_EPI) { if (wr == 0) PG8_BAR; }
        if constexpr (!Epi::AFTER_DRAIN) { E(acc, cur, wr, wc, fr, fq); S.done(cur); }
        if (!has_next) break;
#pragma unroll
        for (int a = 0; a < 2; ++a)
#pragma unroll
            for (int b = 0; b < 2; ++b)
#pragma unroll
                for (int m = 0; m < 4; ++m)
#pragma unroll
                    for (int n = 0; n < 2; ++n) acc[a][b][m][n] = (f32x4){0.f, 0.f, 0.f, 0.f};
        cur = nxt; cA = nA; cB = nB; ++ui;
        if constexpr (ALIGN_EPI) { if (wr == 1) PG8_BAR; }
    }
    PG8_WAIT_V(0);
    if constexpr (!ALIGN_EPI) { if (wr == 0) PG8_BAR; }
    PG8_BAR;
    if constexpr (Epi::AFTER_DRAIN) { E.fused(acc, cur, wr, wc, fr, fq, lds, wid, lane); S.done(cur); }
#undef PG8_SA
#undef PG8_SB
#undef PG8_STAGE
#undef PG8_LDA
#undef PG8_LDB
#undef PG8_MMA
#undef PG8_WAIT_V
#undef PG8_WAIT_L
#undef PG8_BAR
#undef PG8_SCHED
}
}

#define LAS __attribute__((address_space(3)))
typedef unsigned short bf16_t;
typedef short bf16x8 __attribute__((ext_vector_type(8)));
typedef float f32x4 __attribute__((ext_vector_type(4)));
typedef unsigned u32x4 __attribute__((ext_vector_type(4)));
typedef unsigned u32x2 __attribute__((ext_vector_type(2)));

constexpr int D = 1024, NB = 8, SEQ = 2048, NDEC = 128;
constexpr int RMAIN = 16384, RMETA0 = 16384, RDEC0 = 16512, R = 16640, RP = 16512;
constexpr int DIN = 7192, CA = 1536, DFF = 2816, NCH = 33;
constexpr int NA = 3840, LDA_ = 3584, NBW = 3584;
constexpr int NITEM = NB * 4 * NCH;
constexpr float EPS = 1e-6f;
constexpr int NTHR = 512, LDS_BYTES = 147456;

constexpr size_t O_YP = 0, O_YS = 16777216, O_DP = 16908288, O_DCP = 17432576, O_GP = 17469440, O_FCP = 18518016,
                 O_DS = 18563072, O_DCS = 26951680, O_GS = 27541504, O_FCS = 44318720, O_END = 45039616;
constexpr size_t DS_HN = 0, DS_OA = DS_HN + (size_t)R * 1024 * 2, DS_SMALL = DS_OA + (size_t)R * 512 * 2, DS_ATTB = DS_SMALL + (size_t)R * 32 * 4,
                 DS_EGL = DS_ATTB + (size_t)NITEM * 8192, DS_EBL = DS_EGL + 8192, DS_SSO = DS_EBL + (size_t)NITEM * 128 * 4  , DS_END = DS_SSO + (size_t)R * 64 * 4;
static_assert(DS_END <= 16777216ull * 4, "d_out scratch");
constexpr size_t MiB = 1u << 20;
constexpr size_t WS_WTA = 0, WS_WTB = WS_WTA + (size_t)NA * 1024 * 2, WS_WA = WS_WTB + (size_t)NBW * 1024 * 2, WS_WB = WS_WA + 1024 * 512 * 2,
                 WS_WO = WS_WB + 1024 * 1024 * 2, WS_WF1 = WS_WO + 1024 * 1024 * 2, WS_WF2 = WS_WF1 + (size_t)5632 * 1024 * 2,
                 WS_CTL = WS_WF2 + (size_t)1024 * 2816 * 2, WS_BIG = WS_CTL + MiB / 4;
constexpr size_t WS_SS2 = WS_CTL, WS_SS3 = WS_CTL + 128 * 1024, WS_BAR = WS_CTL + 200 * 1024, WS_ZERO = WS_CTL + 216 * 1024  , WS_ONES = WS_CTL + 224 * 1024  , WS_JUNK = WS_CTL + 228 * 1024  ;
constexpr size_t WS_PROJA = WS_BIG, WS_QT = WS_PROJA + (size_t)R * LDA_ * 2, WS_KT = WS_QT + (size_t)RP * 512 * 2, WS_WW = WS_KT + (size_t)RP * 512 * 2,
                 WS_UU = WS_WW + (size_t)RP * 512 * 2, WS_ATTA = WS_UU + (size_t)RP * 512 * 2, WS_OB = WS_ATTA + (size_t)NITEM * 8192, WS_END1 = WS_OB + (size_t)R * 1024 * 2;
static_assert(WS_END1 <= 256 * MiB, "ws map 1");
constexpr size_t WS_Z = WS_BIG, WS_SG = WS_Z + (size_t)R * 1536 * 2;
static_assert(WS_SG + (size_t)R * 2048 * 2 <= WS_QT, "ws map 2");
constexpr size_t WS_MIX = WS_QT;
constexpr size_t WS_HN2 = WS_OB;
constexpr size_t WS_U = WS_BIG, WS_GF = WS_U + (size_t)R * DFF * 2;
constexpr size_t WS_HALO = WS_U, WS_FIXU = WS_HALO + (size_t)512 * DFF * 2, WS_FIXG = WS_FIXU + (size_t)512 * DFF * 2, WS_RAWU = WS_FIXG + (size_t)512 * DFF * 2, WS_RAWG = WS_RAWU + (size_t)256 * DFF * 2;
static_assert(WS_RAWG + (size_t)256 * DFF * 2 <= WS_GF, "side buffers");
static_assert(WS_GF + (size_t)R * DFF * 2 <= WS_HN2, "ws map 3");
static_assert(WS_MIX + (size_t)R * 1024 * 2 <= WS_OB, "ws map 4");

struct Params { const float* in[25]; float* out; unsigned char* ws; int ph_lo, ph_hi; };
enum { I_XP = 0, I_XS, I_SD, I_SDC, I_SG, I_SFC, I_META, I_NMIX, I_WIN, I_WCA, I_ALOG, I_DTB, I_WGK2, I_BGK, I_ONA, I_ONB, I_WAO, I_WBO, I_WO, I_NFFN, I_WFI, I_WCF, I_BCF, I_WFO, I_NFIN };

typedef float f32x2_t __attribute__((ext_vector_type(2)));
typedef __bf16 bf16x2_t __attribute__((ext_vector_type(2)));
__device__ __forceinline__ unsigned pk2(float lo, float hi) { f32x2_t v = {lo, hi}; bf16x2_t b = __builtin_convertvector(v, bf16x2_t); return __builtin_bit_cast(unsigned, b); }
__device__ __forceinline__ unsigned f2bf(float f) { return pk2(f, 0.f) & 0xffffu; }
__device__ __forceinline__ float bflo(unsigned w) { return __builtin_bit_cast(float, w << 16); }
__device__ __forceinline__ float bfhi(unsigned w) { return __builtin_bit_cast(float, w & 0xffff0000u); }
__device__ __forceinline__ float bf2f(bf16_t h) { return __builtin_bit_cast(float, ((unsigned)h) << 16); }
__device__ __forceinline__ void unpack8(u32x4 w, float* f) { f[0] = bflo(w.x); f[1] = bfhi(w.x); f[2] = bflo(w.y); f[3] = bfhi(w.y); f[4] = bflo(w.z); f[5] = bfhi(w.z); f[6] = bflo(w.w); f[7] = bfhi(w.w); }
__device__ __forceinline__ u32x4 pack8(const float* f) { u32x4 w; w.x = pk2(f[0], f[1]); w.y = pk2(f[2], f[3]); w.z = pk2(f[4], f[5]); w.w = pk2(f[6], f[7]); return w; }
__device__ __forceinline__ float wave_sum(float v) {
#pragma unroll
    for (int o = 1; o < 64; o <<= 1) v += __shfl_xor(v, o);
    return v;
}
__device__ __forceinline__ float sigmoidf_(float x) { return __builtin_amdgcn_rcpf(1.f + __expf(-x)); }
__device__ __forceinline__ float siluf_(float x) { return x * __builtin_amdgcn_rcpf(1.f + __expf(-x)); }
__device__ __forceinline__ float softplusf_(float x) { return fmaxf(x, 0.f) + __logf(1.f + __expf(-fabsf(x))); }
__device__ __forceinline__ float gelu_tanh(float x) { const float t = x * (-2.302208198f + -0.1029432397f * x * x); return x * __builtin_amdgcn_rcpf(1.f + __builtin_amdgcn_exp2f(t)); }
#define LDS_WAIT() asm volatile("s_waitcnt lgkmcnt(0)" ::: "memory")
template <int CTRL, int ROWMASK> __device__ __forceinline__ float dpp_add(float v) { return v + __builtin_bit_cast(float, __builtin_amdgcn_update_dpp(0, __builtin_bit_cast(int, v), CTRL, ROWMASK, 0xf, true)); }
__device__ __forceinline__ float wave_incl_scan(float v) {
    v = dpp_add<0x111, 0xf>(v); v = dpp_add<0x112, 0xf>(v); v = dpp_add<0x114, 0xf>(v); v = dpp_add<0x118, 0xf>(v);
    v = dpp_add<0x142, 0xa>(v);
    v = dpp_add<0x143, 0xc>(v);
    return v;
}
__device__ __forceinline__ void lds_barrier() { asm volatile("s_waitcnt lgkmcnt(0)\n\ts_barrier" ::: "memory"); }
#define MFMA16(a, b, c) __builtin_amdgcn_mfma_f32_16x16x32_bf16(a, b, c, 0, 0, 0)
typedef short s16x4 __attribute__((ext_vector_type(4)));
__device__ __forceinline__ s16x4 ldtr(const LAS bf16_t* p) { return __builtin_bit_cast(s16x4, __builtin_amdgcn_ds_read_tr16_b64_v4i16((LAS s16x4*)p)); }
__device__ __forceinline__ bf16x8 trfrag(const LAS bf16_t* base, int stride, int k0, int col0, int fr, int fq) {
    const LAS bf16_t* p0 = base + (k0 + 8 * fq + (fr >> 2)) * stride + col0 + 4 * (fr & 3);
    const s16x4 lo = ldtr(p0), hi = ldtr(p0 + 4 * stride);
    return (bf16x8){lo[0], lo[1], lo[2], lo[3], hi[0], hi[1], hi[2], hi[3]};
}
__device__ __forceinline__ bf16x8 lfrag(const LAS bf16_t* base, int row, int stride, int k0, int q) { return *(const LAS bf16x8*)(base + row * stride + k0 + 8 * q); }

__device__ __forceinline__ const float* xrow_ptr(const Params& p, int row) {
    if (row < RMAIN) return p.in[I_XP] + (size_t)row * D;
    if (row < RDEC0) return p.in[I_META] + (size_t)((row - RMETA0) & 15) * D;
    return p.in[I_XS] + (size_t)(row - RDEC0) * D;
}
__device__ __forceinline__ int prow(int b, int c, int ii) {
    if (c == 0) return ii >= 48 ? RMETA0 + b * 16 + (ii - 48) : -1;
    if (ii >= 0 || c >= 2) return b * SEQ + 64 * (c - 1) + ii;
    return RMETA0 + b * 16 + 16 + ii;
}
__device__ __forceinline__ long yslot(int row) { if (row < RMAIN) return (long)O_YP + (long)row * D; if (row >= RDEC0) return (long)O_YS + (long)(row - RDEC0) * D; return -1; }

__device__ __forceinline__ void transpose_item(const float* W, int ldW, int col0, int K, bf16_t* WT, int row_off, int nblk, LAS float* scr, int item, int lane, int perm) {
    const int kb = item / nblk, nb = item % nblk, k0 = 64 * kb, n0 = 32 * nb;
#pragma unroll 8
    for (int i = 0; i < 32; ++i) { const int kk = 2 * i + (lane >> 5); scr[kk * 33 + (lane & 31)] = W[(size_t)(k0 + kk) * ldW + col0 + n0 + (lane & 31)]; }
    LDS_WAIT();
    const int c = lane & 7;
#pragma unroll
    for (int j = 0; j < 4; ++j) { const int n = (lane >> 3) + 8 * j; const LAS float* s = scr + (8 * c) * 33 + n;
        u32x4 o; o.x = pk2(s[0 * 33], s[1 * 33]); o.y = pk2(s[2 * 33], s[3 * 33]); o.z = pk2(s[4 * 33], s[5 * 33]); o.w = pk2(s[6 * 33], s[7 * 33]);
        const int drow = perm ? (n0 < DFF ? 256 * (n0 >> 7) + (n0 & 127) : 256 * ((n0 - DFF) >> 7) + 128 + ((n0 - DFF) & 127)) + n : row_off + n0 + n;
        *(u32x4*)(WT + (size_t)drow * K + k0 + 8 * c) = o; }
    LDS_WAIT();
}
struct Seg { const float* W; int ldW, col0, K, ncols; bf16_t* WT; int row_off; int perm; };

template <int SG_LO, int SG_HI> __device__ __forceinline__ void transpose_segs(const Params& p, LAS unsigned char* lds, int widx, int nw) {
    const int lane = threadIdx.x & 63, wave = threadIdx.x >> 6;
    unsigned char* ws = p.ws; LAS float* scr = (LAS float*)(lds + wave * 16384);
    bf16_t* WTA = (bf16_t*)(ws + WS_WTA); bf16_t* WTB = (bf16_t*)(ws + WS_WTB); const float* win = p.in[I_WIN];
#pragma unroll
    for (int sg = SG_LO; sg < SG_HI; ++sg) {
        Seg s;
        switch (sg) {
            case 0: s = Seg{win, DIN, 0, 1024, 1536, WTA, 0, 0}; break;
            case 1: s = Seg{win, DIN, 2056, 1024, 1024, WTA, 1536, 0}; break;
            case 2: s = Seg{win, DIN, 3080, 1024, 1024, WTA, 2560, 0}; break;
            case 3: s = Seg{win, DIN, 1536, 1024, 512, WTB, 0, 0}; break;
            case 4: s = Seg{win, DIN, 4104, 1024, 1024, WTB, 512, 0}; break;
            case 5: s = Seg{win, DIN, 5144, 1024, 2048, WTB, 1536, 0}; break;
            case 6: s = Seg{p.in[I_WAO], 1024, 0, 512, 1024, (bf16_t*)(ws + WS_WA), 0, 0}; break;
            case 7: s = Seg{p.in[I_WBO], 1024, 0, 1024, 1024, (bf16_t*)(ws + WS_WB), 0, 0}; break;
            case 8: s = Seg{p.in[I_WO], 1024, 0, 1024, 1024, (bf16_t*)(ws + WS_WO), 0, 0}; break;
            case 9: s = Seg{p.in[I_WFI], 5632, 0, 1024, 5632, (bf16_t*)(ws + WS_WF1), 0, 1}; break;
            default: s = Seg{p.in[I_WFO], 1024, 0, 2816, 1024, (bf16_t*)(ws + WS_WF2), 0, 0}; break;
        }
        const int nblk = s.ncols / 32, nit = (s.K / 64) * nblk;
        for (int it = widx; it < nit; it += nw) transpose_item(s.W, s.ldW, s.col0, s.K, s.WT, s.row_off, nblk, scr, it, lane, s.perm);
    }
}
template <int SG_LO, int SG_HI> __device__ __forceinline__ void transposes_in_idle_slots(const Params& p, LAS unsigned char* lds, int nwg) {
    const int G = gridDim.x, wave = threadIdx.x >> 6, rounds = (nwg + G - 1) / G, first_short = nwg - (rounds - 1) * G;
    if (first_short < G) { if ((int)blockIdx.x >= first_short) transpose_segs<SG_LO, SG_HI>(p, lds, ((int)blockIdx.x - first_short) * 8 + wave, (G - first_short) * 8); }
    else transpose_segs<SG_LO, SG_HI>(p, lds, (int)blockIdx.x * 8 + wave, G * 8);
}

__device__ __forceinline__ void p0_prologue(const Params& p, LAS unsigned char* lds) {
    const int tid = threadIdx.x, lane = tid & 63, wave = tid >> 6;
    const int gw = blockIdx.x * 8 + wave, NGW = gridDim.x * 8;
    unsigned char* ws = p.ws;
    LAS float* scr = (LAS float*)(lds + wave * 16384);
    bf16_t* WTA = (bf16_t*)(ws + WS_WTA); bf16_t* WTB = (bf16_t*)(ws + WS_WTB);
    const float* win = p.in[I_WIN];
    transpose_segs<0, 6>(p, lds, gw, NGW);
    const int gt = blockIdx.x * NTHR + tid, NGT = gridDim.x * NTHR;
    for (int e = gt; e < 256 * 1024; e += NGT) {
        const int c = e >> 10, k = e & 1023; float v = 0.f;
        if (c < 8) v = win[(size_t)k * DIN + 2048 + c]; else if (c < 24) v = win[(size_t)k * DIN + 5128 + (c - 8)];
        WTA[(size_t)(3584 + c) * 1024 + k] = (bf16_t)f2bf(v);
    }
    for (int e = gt; e < 224 * 256; e += NGT) ((float*)(ws + WS_CTL))[e] = 0.f;
    if (gt < 256) ((float*)(ws + WS_ONES))[gt] = 1.f;
    bf16_t* HN = (bf16_t*)((unsigned char*)p.out + DS_HN);
    const float* nw = p.in[I_NMIX];
    for (int row0 = gw; row0 < R; row0 += 2 * NGW) {
        f32x4 v[2][4]; float ssum[2];
#pragma unroll
        for (int u = 0; u < 2; ++u) { const int row = row0 + u * NGW; ssum[u] = 0.f;
            if (row < R) { const f32x4* xr = (const f32x4*)xrow_ptr(p, row) + lane;
#pragma unroll
                for (int j = 0; j < 4; ++j) v[u][j] = xr[64 * j]; } }
#pragma unroll
        for (int u = 0; u < 2; ++u) { const int row = row0 + u * NGW;
            if (row < R) {
#pragma unroll
                for (int j = 0; j < 4; ++j) ssum[u] += (v[u][j].x * v[u][j].x + v[u][j].y * v[u][j].y) + (v[u][j].z * v[u][j].z + v[u][j].w * v[u][j].w);
                const float rstd = rsqrtf(wave_sum(ssum[u]) * (1.f / D) + EPS);
                u32x2* o = (u32x2*)(HN + (size_t)row * D) + lane;
#pragma unroll
                for (int j = 0; j < 4; ++j) { const f32x4 w = ((const f32x4*)nw)[lane + 64 * j]; u32x2 q; q.x = pk2(v[u][j].x * rstd * w.x, v[u][j].y * rstd * w.y); q.y = pk2(v[u][j].z * rstd * w.z, v[u][j].w * rstd * w.w); o[64 * j] = q; }
            } }
    }
}

struct FA {
    static constexpr bool HAS_SS = false; static constexpr int MB = 4;
    bf16_t* PA; float* SM;
    struct Pre {}; __device__ __forceinline__ Pre pre(int, int) const { return Pre{}; }
    __device__ __forceinline__ float operator()(int row, int col, f32x4 a, f32x4 b, Pre) const {
        if (col < LDA_) { u32x4 w; w.x = pk2(a.x, a.y); w.y = pk2(a.z, a.w); w.z = pk2(b.x, b.y); w.w = pk2(b.z, b.w); *(u32x4*)(PA + (size_t)row * LDA_ + col) = w; }
        else { const int c = col - LDA_; if (c < 24) { float* o = SM + (size_t)row * 32 + c; *(f32x4*)o = a; *(f32x4*)(o + 4) = b; } }
        return 0.f;
    }
    __device__ __forceinline__ void add_ss(int, float) const {}
};
struct FB {
    static constexpr bool HAS_SS = false; static constexpr int MB = 2;
    bf16_t* OA; bf16_t* OB; const float* SSO; const float* ona; const float* onb; bf16_t* SGp;
    struct Pre { u32x4 o; f32x4 s0, s1; };
    __device__ __forceinline__ Pre pre(int row, int col) const {
        Pre r;
        if (col < 1536) {
            const int hidx = col < 512 ? (col >> 7) : 4 + ((col - 512) >> 8);
            const bf16_t* op = col < 512 ? OA + (size_t)row * 512 + col : OB + (size_t)row * 1024 + (col - 512);
            r.o = *(const u32x4*)op; const f32x4* sp = (const f32x4*)(SSO + ((size_t)row * 8 + hidx) * 8); r.s0 = sp[0]; r.s1 = sp[1];
        } else { r.o = (u32x4){0u, 0u, 0u, 0u}; r.s0 = (f32x4){0.f, 0.f, 0.f, 0.f}; r.s1 = r.s0; }
        return r;
    }
    __device__ __forceinline__ float operator()(int row, int col, f32x4 a, f32x4 b, Pre pr) const {
        if (col < 1536) {
            const bool isA = col < 512; const int c2 = col - 512;
            const float ss = ((pr.s0.x + pr.s0.y) + (pr.s0.z + pr.s0.w)) + ((pr.s1.x + pr.s1.y) + (pr.s1.z + pr.s1.w));
            const float rs = rsqrtf(ss * (isA ? 1.f / 128.f : 1.f / 256.f) + EPS);
            const float* nw = isA ? ona + (col & 127) : onb + (c2 & 255);
            const f32x4 n0 = *(const f32x4*)nw, n1 = *(const f32x4*)(nw + 4);
            float o[8]; unpack8(pr.o, o);
            const float z[8] = {a.x, a.y, a.z, a.w, b.x, b.y, b.z, b.w}; const float nn[8] = {n0.x, n0.y, n0.z, n0.w, n1.x, n1.y, n1.z, n1.w};
#pragma unroll
            for (int e = 0; e < 8; ++e) o[e] = o[e] * rs * nn[e] * siluf_(z[e]);
            bf16_t* op = isA ? OA + (size_t)row * 512 + col : OB + (size_t)row * 1024 + c2;
            *(u32x4*)op = pack8(o);
        } else { u32x4 w; w.x = pk2(sigmoidf_(a.x), sigmoidf_(a.y)); w.y = pk2(sigmoidf_(a.z), sigmoidf_(a.w)); w.z = pk2(sigmoidf_(b.x), sigmoidf_(b.y)); w.w = pk2(sigmoidf_(b.z), sigmoidf_(b.w));
               *(u32x4*)(SGp + (size_t)row * 2048 + (col - 1536)) = w; }
        return 0.f;
    }
    __device__ __forceinline__ void add_ss(int, float) const {}
};
template <int SECOND> struct FMix {
    static constexpr bool HAS_SS = false; static constexpr int MB = 4;
    const bf16_t* SGp; bf16_t* MIX;
    struct Pre { u32x4 g, m; };
    __device__ __forceinline__ Pre pre(int row, int col) const { Pre r; r.g = *(const u32x4*)(SGp + (size_t)row * 2048 + SECOND * 1024 + col);
        if (SECOND) r.m = *(const u32x4*)(MIX + (size_t)row * 1024 + col); else r.m = (u32x4){0u, 0u, 0u, 0u}; return r; }
    __device__ __forceinline__ float operator()(int row, int col, f32x4 a, f32x4 b, Pre pr) const {
        float g[8], v[8] = {a.x, a.y, a.z, a.w, b.x, b.y, b.z, b.w};
        unpack8(pr.g, g);
        u32x4* mp = (u32x4*)(MIX + (size_t)row * 1024 + col);
        if (SECOND) { float m[8]; unpack8(pr.m, m);
#pragma unroll
            for (int i = 0; i < 8; ++i) v[i] = m[i] + g[i] * v[i]; }
        else {
#pragma unroll
            for (int i = 0; i < 8; ++i) v[i] = g[i] * v[i]; }
        *mp = pack8(v);
        return 0.f;
    }
    __device__ __forceinline__ void add_ss(int, float) const {}
};
struct FX2 {
    static constexpr bool HAS_SS = true; static constexpr int MB = 4;
    const float* xp_; const float* meta_; const float* xs_; float* out_; const float* nffn_; bf16_t* HN2; float* SS2;
    struct Pre { f32x4 x0, x1; };
    __device__ __forceinline__ Pre pre(int row, int col) const {
        const float* xr = (row < RMAIN ? xp_ + (size_t)row * D : (row < RDEC0 ? meta_ + (size_t)((row - RMETA0) & 15) * D : xs_ + (size_t)(row - RDEC0) * D)) + col;
        Pre r; r.x0 = *(const f32x4*)xr; r.x1 = *(const f32x4*)(xr + 4); return r; }
    __device__ __forceinline__ float operator()(int row, int col, f32x4 a, f32x4 b, Pre pr) const {
        a = a + pr.x0; b = b + pr.x1;
        const long ys = yslot(row);
        if (ys >= 0) { float* o = out_ + ys + col; *(f32x4*)o = a; *(f32x4*)(o + 4) = b; }
        const float* nw = nffn_ + col; const f32x4 w0 = *(const f32x4*)nw, w1 = *(const f32x4*)(nw + 4);
        u32x4 w; w.x = pk2(a.x * w0.x, a.y * w0.y); w.y = pk2(a.z * w0.z, a.w * w0.w); w.z = pk2(b.x * w1.x, b.y * w1.y); w.w = pk2(b.z * w1.z, b.w * w1.w);
        *(u32x4*)(HN2 + (size_t)row * 1024 + col) = w;
        return (a.x * a.x + a.y * a.y) + (a.z * a.z + a.w * a.w) + (b.x * b.x + b.y * b.y) + (b.z * b.z + b.w * b.w);
    }
    __device__ __forceinline__ void add_ss(int row, float s) const { atomicAdd(SS2 + row, s); }
};
struct FF1 {
    static constexpr bool HAS_SS = false; static constexpr int MB = 4;
    const float* SS2; bf16_t* U; bf16_t* GF;
    struct Pre { float ss; }; __device__ __forceinline__ Pre pre(int row, int) const { return Pre{SS2[row]}; }
    __device__ __forceinline__ float operator()(int row, int col, f32x4 a, f32x4 b, Pre pr) const {
        const float rs = rsqrtf(pr.ss * (1.f / D) + EPS);
        u32x4 w; w.x = pk2(a.x * rs, a.y * rs); w.y = pk2(a.z * rs, a.w * rs); w.z = pk2(b.x * rs, b.y * rs); w.w = pk2(b.z * rs, b.w * rs);
        bf16_t* o = col < DFF ? U + (size_t)row * DFF + col : GF + (size_t)row * DFF + (col - DFF);
        *(u32x4*)o = w;
        return 0.f;
    }
    __device__ __forceinline__ void add_ss(int, float) const {}
};
struct FF2 {
    static constexpr bool HAS_SS = true; static constexpr int MB = 4;
    float* out; float* SS3;
    struct Pre { f32x4 x0, x1; };
    __device__ __forceinline__ Pre pre(int row, int col) const { Pre r; const long ys = yslot(row);
        if (ys >= 0) { const float* o = out + ys + col; r.x0 = *(const f32x4*)o; r.x1 = *(const f32x4*)(o + 4); } else { r.x0 = (f32x4){0.f, 0.f, 0.f, 0.f}; r.x1 = r.x0; } return r; }
    __device__ __forceinline__ float operator()(int row, int col, f32x4 a, f32x4 b, Pre pr) const {
        const long ys = yslot(row); if (ys < 0) return 0.f;
        float* o = out + ys + col;
        a = a + pr.x0; b = b + pr.x1;
        *(f32x4*)o = a; *(f32x4*)(o + 4) = b;
        return (a.x * a.x + a.y * a.y) + (a.z * a.z + a.w * a.w) + (b.x * b.x + b.y * b.y) + (b.z * b.z + b.w * b.w);
    }
    __device__ __forceinline__ void add_ss(int row, float s) const { atomicAdd(SS3 + row, s); }
};

template <int CTRL> __device__ __forceinline__ float dpp_f(float v) { return __builtin_bit_cast(float, __builtin_amdgcn_update_dpp(0, __builtin_bit_cast(int, v), CTRL, 0xf, 0xf, false)); }
struct EpiAct {
    static constexpr bool PERM = true, AFTER_DRAIN = false;
    unsigned char* wsb; const float* wcf; const float* bcf;
    __device__ __forceinline__ void operator()(const f32x4 (&acc)[2][2][4][2], const pg8::Unit& u, int wr, int wc, int fr, int fq) const {
        { int lane_ = (int)__builtin_amdgcn_mbcnt_hi(~0u, __builtin_amdgcn_mbcnt_lo(~0u, 0u)); asm volatile("" : "+v"(lane_)); fr = lane_ & 15; fq = lane_ >> 4; }
        const float* SS2 = (const float*)(wsb + WS_SS2); bf16_t* ACT = (bf16_t*)(wsb + WS_GF); bf16_t* HALO = (bf16_t*)(wsb + WS_HALO); bf16_t* FIXU = (bf16_t*)(wsb + WS_FIXU);
        bf16_t* FIXG = (bf16_t*)(wsb + WS_FIXG); bf16_t* RAWU = (bf16_t*)(wsb + WS_RAWU); bf16_t* RAWG = (bf16_t*)(wsb + WS_RAWG);
        const int cu0 = u.pn * 128 + wc * 32 + 8 * fq;
        if (u.pm == RMAIN / 256) {
#pragma unroll
            for (int ai = 0; ai < 2; ++ai)
#pragma unroll
                for (int m = 0; m < 4; ++m) {
                    const int lr = ai * 128 + wr * 64 + m * 16 + fr; const float rs = rsqrtf(SS2[RMAIN + lr] * (1.f / D) + EPS);
                    const f32x4 a0 = acc[ai][0][m][0] * rs, a1 = acc[ai][0][m][1] * rs, g0 = acc[ai][1][m][0] * rs, g1 = acc[ai][1][m][1] * rs;
                    u32x4 w; w.x = pk2(a0.x, a0.y); w.y = pk2(a0.z, a0.w); w.z = pk2(a1.x, a1.y); w.w = pk2(a1.z, a1.w); *(u32x4*)(RAWU + (size_t)lr * DFF + cu0) = w;
                    w.x = pk2(g0.x, g0.y); w.y = pk2(g0.z, g0.w); w.z = pk2(g1.x, g1.y); w.w = pk2(g1.z, g1.w); *(u32x4*)(RAWG + (size_t)lr * DFF + cu0) = w;
                }
            return;
        }
#pragma unroll
        for (int ai = 0; ai < 2; ++ai) {
            const int rowb = u.pm * 256 + ai * 128 + wr * 64, blk = rowb >> 6;
            float rs[4];
#pragma unroll
            for (int m = 0; m < 4; ++m) rs[m] = rsqrtf(SS2[rowb + m * 16 + fr] * (1.f / D) + EPS);
#pragma unroll
            for (int n = 0; n < 2; ++n) {
                const int c0 = cu0 + 4 * n;
                const f32x4 w0 = *(const f32x4*)(wcf + c0), w1 = *(const f32x4*)(wcf + DFF + c0), w2 = *(const f32x4*)(wcf + 2 * DFF + c0), bb = *(const f32x4*)(bcf + c0);
                float act[4][4];
#pragma unroll
                for (int j = 0; j < 4; ++j) {
                    float uv[4], gv[4], r1[4], r2[4];
#pragma unroll
                    for (int m = 0; m < 4; ++m) { uv[m] = acc[ai][0][m][n][j] * rs[m]; gv[m] = acc[ai][1][m][n][j] * rs[m]; r1[m] = dpp_f<0x121>(uv[m]); r2[m] = dpp_f<0x122>(uv[m]); }
#pragma unroll
                    for (int m = 0; m < 4; ++m) {
                        const float p1 = fr >= 1 ? r1[m] : (m > 0 ? r1[m > 0 ? m - 1 : 0] : 0.f);
                        const float p2 = fr >= 2 ? r2[m] : (m > 0 ? r2[m > 0 ? m - 1 : 0] : 0.f);
                        act[m][j] = gelu_tanh(w0[j] * p2 + w1[j] * p1 + w2[j] * uv[m] + bb[j]) * gv[m];
                    }
                    if (fr >= 14) HALO[(size_t)(blk * 2 + fr - 14) * DFF + c0 + j] = (bf16_t)f2bf(uv[3]);
                    if (fr < 2) { FIXU[(size_t)(blk * 2 + fr) * DFF + c0 + j] = (bf16_t)f2bf(uv[0]); FIXG[(size_t)(blk * 2 + fr) * DFF + c0 + j] = (bf16_t)f2bf(gv[0]); }
                }
#pragma unroll
                for (int m = 0; m < 4; ++m)
                    if (m > 0 || fr >= 2) { u32x2 w; w.x = pk2(act[m][0], act[m][1]); w.y = pk2(act[m][2], act[m][3]); *(u32x2*)(ACT + (size_t)(rowb + m * 16 + fr) * DFF + c0) = w; }
            }
        }
    }
};
__device__ __forceinline__ void p_fix(const Params& p) {
    const bf16_t* HALO = (const bf16_t*)(p.ws + WS_HALO); const bf16_t* FIXU = (const bf16_t*)(p.ws + WS_FIXU); const bf16_t* FIXG = (const bf16_t*)(p.ws + WS_FIXG);
    const bf16_t* RAWU = (const bf16_t*)(p.ws + WS_RAWU); const bf16_t* RAWG = (const bf16_t*)(p.ws + WS_RAWG); bf16_t* ACT = (bf16_t*)(p.ws + WS_GF);
    const float* wf = p.in[I_WCF]; const float* bfc = p.in[I_BCF];
    const int gt = blockIdx.x * NTHR + threadIdx.x, NGT = gridDim.x * NTHR;
    constexpr int NC8 = DFF / 8, N1 = 256 * NC8, N2 = NB * NC8, N3 = NDEC * NC8;
    for (int wi = gt; wi < N1 + N2 + N3; wi += NGT) {
        const int c8 = wi % NC8, col = 8 * c8; int q = wi / NC8;
        float w0[8], w1[8], w2[8], bb[8];
#pragma unroll
        for (int e = 0; e < 8; ++e) { w0[e] = wf[col + e]; w1[e] = wf[DFF + col + e]; w2[e] = wf[2 * DFF + col + e]; bb[e] = bfc[col + e]; }
        if (q < 256) {
            const int j = q; float p2[8], p1[8], u0[8], u1[8], g0[8], g1[8], o[8];
            if (j & 31) { unpack8(*(const u32x4*)(HALO + (size_t)(2 * (j - 1)) * DFF + col), p2); unpack8(*(const u32x4*)(HALO + (size_t)(2 * (j - 1) + 1) * DFF + col), p1); }
            else { const int b = j >> 5; unpack8(*(const u32x4*)(RAWU + (size_t)(16 * b + 14) * DFF + col), p2); unpack8(*(const u32x4*)(RAWU + (size_t)(16 * b + 15) * DFF + col), p1); }
            unpack8(*(const u32x4*)(FIXU + (size_t)(2 * j) * DFF + col), u0); unpack8(*(const u32x4*)(FIXU + (size_t)(2 * j + 1) * DFF + col), u1);
            unpack8(*(const u32x4*)(FIXG + (size_t)(2 * j) * DFF + col), g0); unpack8(*(const u32x4*)(FIXG + (size_t)(2 * j + 1) * DFF + col), g1);
#pragma unroll
            for (int e = 0; e < 8; ++e) o[e] = gelu_tanh(w0[e] * p2[e] + w1[e] * p1[e] + w2[e] * u0[e] + bb[e]) * g0[e];
            *(u32x4*)(ACT + (size_t)(64 * j) * DFF + col) = pack8(o);
#pragma unroll
            for (int e = 0; e < 8; ++e) o[e] = gelu_tanh(w0[e] * p1[e] + w1[e] * u0[e] + w2[e] * u1[e] + bb[e]) * g1[e];
            *(u32x4*)(ACT + (size_t)(64 * j + 1) * DFF + col) = pack8(o);
            if ((j & 31) == 31) {
                float h0[8], h1[8]; unpack8(*(const u32x4*)(HALO + (size_t)(2 * j) * DFF + col), h0); unpack8(*(const u32x4*)(HALO + (size_t)(2 * j + 1) * DFF + col), h1);
                float* so = p.out + O_FCP + (size_t)((j >> 5) * 2) * DFF + col;
#pragma unroll
                for (int e = 0; e < 8; ++e) { so[e] = h0[e]; so[DFF + e] = h1[e]; }
            }
        } else if (q < 256 + NB) {
            const int b = q - 256; float p2[8], p1[8];
#pragma unroll
            for (int e = 0; e < 8; ++e) { p2[e] = 0.f; p1[e] = 0.f; }
            for (int t = 0; t < 16; ++t) {
                const int lr = 16 * b + t; float uu[8], g[8], o[8];
                unpack8(*(const u32x4*)(RAWU + (size_t)lr * DFF + col), uu); unpack8(*(const u32x4*)(RAWG + (size_t)lr * DFF + col), g);
#pragma unroll
                for (int e = 0; e < 8; ++e) { o[e] = gelu_tanh(w0[e] * p2[e] + w1[e] * p1[e] + w2[e] * uu[e] + bb[e]) * g[e]; p2[e] = p1[e]; p1[e] = uu[e]; }
                *(u32x4*)(ACT + (size_t)(RMETA0 + lr) * DFF + col) = pack8(o);
            }
        } else {
            const int n = q - 256 - NB, lr = 128 + n; float uu[8], g[8], o[8];
            const float* s0 = p.in[I_SFC] + (size_t)n * 2 * DFF + col; const float* s1 = s0 + DFF;
            unpack8(*(const u32x4*)(RAWU + (size_t)lr * DFF + col), uu); unpack8(*(const u32x4*)(RAWG + (size_t)lr * DFF + col), g);
            float* so = p.out + O_FCS + (size_t)n * 2 * DFF + col;
#pragma unroll
            for (int e = 0; e < 8; ++e) { o[e] = gelu_tanh(w0[e] * s0[e] + w1[e] * s1[e] + w2[e] * uu[e] + bb[e]) * g[e]; so[e] = s1[e]; so[DFF + e] = uu[e]; }
            *(u32x4*)(ACT + (size_t)(RDEC0 + n) * DFF + col) = pack8(o);
        }
    }
}

template <class F> __device__ __forceinline__ void thin_gemm(LAS unsigned char* lds, const bf16_t* A, const bf16_t* Bt, int K, int N, int row0, const F& f) {
    const int tid = threadIdx.x, lane = tid & 63, wave = tid >> 6, fr = lane & 15, fq = lane >> 4;
    LAS float* red = (LAS float*)lds;
    const int nct = N / 32, ntiles = 8 * nct, nks = K / 32;
    for (int tile = blockIdx.x; tile < ntiles; tile += gridDim.x) {
        const int rt = tile & 7, ct = tile >> 3;
        f32x4 acc[2][2];
#pragma unroll
        for (int i = 0; i < 2; ++i)
#pragma unroll
            for (int j = 0; j < 2; ++j) acc[i][j] = (f32x4){0.f, 0.f, 0.f, 0.f};
        const bf16_t* ap = A + (size_t)(row0 + rt * 32 + fr) * K + 8 * fq;
        const bf16_t* bp = Bt + (size_t)(ct * 32 + fr) * K + 8 * fq;
        const int per = (nks + 7) >> 3, ks0 = wave * per, ks1 = (ks0 + per < nks) ? ks0 + per : nks;
        for (int kb = ks0; kb < ks1; kb += 6) {
            bf16x8 a0[6], a1[6], b0[6], b1[6];
#pragma unroll
            for (int u = 0; u < 6; ++u) if (kb + u < ks1) { const int ks = kb + u;
                a0[u] = *(const bf16x8*)(ap + ks * 32); a1[u] = *(const bf16x8*)(ap + (size_t)16 * K + ks * 32);
                b0[u] = *(const bf16x8*)(bp + ks * 32); b1[u] = *(const bf16x8*)(bp + (size_t)16 * K + ks * 32); }
#pragma unroll
            for (int u = 0; u < 6; ++u) if (kb + u < ks1) {
                acc[0][0] = MFMA16(b0[u], a0[u], acc[0][0]); acc[0][1] = MFMA16(b1[u], a0[u], acc[0][1]);
                acc[1][0] = MFMA16(b0[u], a1[u], acc[1][0]); acc[1][1] = MFMA16(b1[u], a1[u], acc[1][1]); }
        }
        lds_barrier();
#pragma unroll
        for (int i = 0; i < 2; ++i)
#pragma unroll
            for (int j = 0; j < 2; ++j)
#pragma unroll
                for (int r = 0; r < 4; ++r) red[wave * 1056 + (16 * i + fr) * 33 + 16 * j + 4 * fq + r] = acc[i][j][r];
        lds_barrier();
        if (tid < 128) {
            const int rr = tid >> 2, c8 = tid & 3; float v[8];
#pragma unroll
            for (int e = 0; e < 8; ++e) { float s = 0.f;
#pragma unroll
                for (int w = 0; w < 8; ++w) s += red[w * 1056 + rr * 33 + c8 * 8 + e];
                v[e] = s; }
            const int row = row0 + rt * 32 + rr;
            const float ss = f(row, ct * 32 + c8 * 8, (f32x4){v[0], v[1], v[2], v[3]}, (f32x4){v[4], v[5], v[6], v[7]}, f.pre(row, ct * 32 + c8 * 8));
            if (F::HAS_SS) f.add_ss(row, ss);
        }
    }
    lds_barrier();
}

constexpr int SQ = 136, SK = 72, SM_ = 68;
constexpr int L_QS = 0, L_KS = L_QS + 64 * SQ * 2, L_KBS = L_KS + 64 * SQ * 2, L_VBT = L_KBS + 64 * SQ * 2, L_KGT = L_VBT + 64 * SQ * 2,
              L_MF = L_KGT + 64 * SQ * 2, L_TF = L_MF + 64 * SM_ * 4, L_TB = L_TF + 64 * SM_ * 4, L_G = L_TB + 64 * SK * 2, L_P = L_G + 1024, L_END2 = L_P + 2 * 16 * 17 * 4 + 1536 * 4;
static_assert(L_END2 <= LDS_BYTES, "P2 LDS");

__device__ __forceinline__ void p2_delta_item(const Params& p, LAS unsigned char* lds, int item) {
    int tid_ = threadIdx.x; asm volatile("" : "+v"(tid_));
    const int tid = tid_, lane = tid & 63, wave = tid >> 6, fr = lane & 15, fq = lane >> 4;
    const int c = item % NCH, bh = item / NCH, h = bh & 3, b = bh >> 2;
    unsigned char* ws = p.ws;
    const bf16_t* PA = (const bf16_t*)(ws + WS_PROJA);
    const float* SMALL = (const float*)((unsigned char*)p.out + DS_SMALL);
    LAS bf16_t* qs = (LAS bf16_t*)(lds + L_QS); LAS bf16_t* ks = (LAS bf16_t*)(lds + L_KS); LAS bf16_t* kbs = (LAS bf16_t*)(lds + L_KBS);
    LAS bf16_t* vbT = (LAS bf16_t*)(lds + L_VBT); LAS bf16_t* kgT = (LAS bf16_t*)(lds + L_KGT);
    LAS float* Mf = (LAS float*)(lds + L_MF); LAS float* Tf = (LAS float*)(lds + L_TF); LAS bf16_t* Tb = (LAS bf16_t*)(lds + L_TB);
    LAS float* gs = (LAS float*)(lds + L_G); LAS float* Gs = gs + 64; LAS float* Pf = (LAS float*)(lds + L_P);
    const int i = tid >> 3, cgp = tid & 7;
    const int row = prow(b, c, i);
    u32x4 xo[3][2], xh[3][2];
    const int hrow = tid < 24 ? prow(b, c, (tid >> 3) - 3) : -1;
#pragma unroll
    for (int sel = 0; sel < 3; ++sel) {
        if (row >= 0) { const u32x4* xp = (const u32x4*)(PA + (size_t)row * LDA_ + sel * 512 + h * 128 + 16 * cgp); xo[sel][0] = xp[0]; xo[sel][1] = xp[1]; }
        else { xo[sel][0] = (u32x4){0u, 0u, 0u, 0u}; xo[sel][1] = (u32x4){0u, 0u, 0u, 0u}; }
        if (hrow >= 0) { const u32x4* xp = (const u32x4*)(PA + (size_t)hrow * LDA_ + sel * 512 + h * 128 + 16 * cgp); xh[sel][0] = xp[0]; xh[sel][1] = xp[1]; }
        else { xh[sel][0] = (u32x4){0u, 0u, 0u, 0u}; xh[sel][1] = (u32x4){0u, 0u, 0u, 0u}; }
    }
    LAS bf16_t* xs = (LAS bf16_t*)(lds + L_MF);
    float sb_ = 0.f, sa_ = 0.f;
    if (row >= 0) { sb_ = SMALL[(size_t)row * 32 + h]; sa_ = SMALL[(size_t)row * 32 + 4 + h]; }
    LAS float* wcs = (LAS float*)(lds + L_P + 2 * 16 * 17 * 4);
    for (int e = tid; e < 1536; e += NTHR) { const int j = e / 384, r = e % 384; wcs[e] = p.in[I_WCA][j * CA + (r >> 7) * 512 + h * 128 + (r & 127)]; }
    float beta = 0.f, g = 0.f;
    if (row >= 0) { beta = sigmoidf_(sb_); g = -__expf(p.in[I_ALOG][h]) * softplusf_(sa_ + p.in[I_DTB][h]); }
    if (cgp == 0) gs[i] = g;
    lds_barrier();
    if (wave == 0) {
        Gs[lane] = wave_incl_scan(gs[lane]);
    }
    lds_barrier();
    const float Gi = Gs[i], Gl = Gs[63];
    const float eg = __expf(Gi), egl = __expf(Gl - Gi);
    if (tid == 0) ((float*)((unsigned char*)p.out + DS_EGL))[item] = __expf(Gl);
#pragma unroll
    for (int sel = 0; sel < 3; ++sel) {
        if (sel > 0) lds_barrier();
        *(LAS u32x4*)(xs + (i + 3) * SQ + 16 * cgp) = xo[sel][0]; *(LAS u32x4*)(xs + (i + 3) * SQ + 16 * cgp + 8) = xo[sel][1];
        if (tid < 24) { *(LAS u32x4*)(xs + (tid >> 3) * SQ + 16 * cgp) = xh[sel][0]; *(LAS u32x4*)(xs + (tid >> 3) * SQ + 16 * cgp + 8) = xh[sel][1]; }
        lds_barrier();
        float y[16];
#pragma unroll
        for (int e = 0; e < 16; ++e) y[e] = 0.f;
#pragma unroll
        for (int j = 0; j < 4; ++j) {
            float x[16]; unpack8(*(const LAS u32x4*)(xs + (i + j) * SQ + 16 * cgp), x); unpack8(*(const LAS u32x4*)(xs + (i + j) * SQ + 16 * cgp + 8), x + 8);
            const LAS f32x4* wc = (const LAS f32x4*)(wcs + j * 384 + sel * 128 + 16 * cgp);
#pragma unroll
            for (int e4 = 0; e4 < 4; ++e4) { const f32x4 w = wc[e4]; y[4 * e4] += w.x * x[4 * e4]; y[4 * e4 + 1] += w.y * x[4 * e4 + 1]; y[4 * e4 + 2] += w.z * x[4 * e4 + 2]; y[4 * e4 + 3] += w.w * x[4 * e4 + 3]; }
            if (j == 3 && c == NCH - 1 && i >= 61) {
                f32x4* o = (f32x4*)(p.out + O_DCP + (size_t)(b * 3 + (i - 61)) * CA + sel * 512 + h * 128 + 16 * cgp);
#pragma unroll
                for (int e4 = 0; e4 < 4; ++e4) o[e4] = (f32x4){x[4 * e4], x[4 * e4 + 1], x[4 * e4 + 2], x[4 * e4 + 3]};
            }
        }
        float ss = 0.f;
#pragma unroll
        for (int e = 0; e < 16; ++e) { y[e] = siluf_(y[e]); ss += y[e] * y[e]; }
        ss += __shfl_xor(ss, 1); ss += __shfl_xor(ss, 2); ss += __shfl_xor(ss, 4);
        float t[16];
        if (sel == 0) {
            const float rq = rsqrtf(ss + EPS) * 0.08838834764831845f;
#pragma unroll
            for (int e = 0; e < 16; ++e) y[e] *= rq;
            *(LAS u32x4*)(qs + i * SQ + 16 * cgp) = pack8(y); *(LAS u32x4*)(qs + i * SQ + 16 * cgp + 8) = pack8(y + 8);
            if (row >= 0) {
#pragma unroll
                for (int e = 0; e < 16; ++e) t[e] = y[e] * eg;
                u32x4* o = (u32x4*)((bf16_t*)(ws + WS_QT) + (size_t)row * 512 + h * 128 + 16 * cgp); o[0] = pack8(t); o[1] = pack8(t + 8);
            }
        } else if (sel == 1) {
            const float rk = rsqrtf(ss + EPS);
#pragma unroll
            for (int e = 0; e < 16; ++e) y[e] *= rk;
            *(LAS u32x4*)(ks + i * SQ + 16 * cgp) = pack8(y); *(LAS u32x4*)(ks + i * SQ + 16 * cgp + 8) = pack8(y + 8);
            if (row >= 0) {
#pragma unroll
                for (int e = 0; e < 16; ++e) t[e] = y[e] * egl;
                u32x4* o = (u32x4*)((bf16_t*)(ws + WS_KT) + (size_t)row * 512 + h * 128 + 16 * cgp); o[0] = pack8(t); o[1] = pack8(t + 8);
            }
#pragma unroll
            for (int e = 0; e < 16; ++e) t[e] = y[e] * beta;
            *(LAS u32x4*)(kbs + i * SQ + 16 * cgp) = pack8(t); *(LAS u32x4*)(kbs + i * SQ + 16 * cgp + 8) = pack8(t + 8);
#pragma unroll
            for (int e = 0; e < 16; ++e) t[e] *= eg;
            *(LAS u32x4*)(kgT + i * SQ + 16 * cgp) = pack8(t); *(LAS u32x4*)(kgT + i * SQ + 16 * cgp + 8) = pack8(t + 8);
        } else {
#pragma unroll
            for (int e = 0; e < 16; ++e) t[e] = y[e] * beta;
            *(LAS u32x4*)(vbT + i * SQ + 16 * cgp) = pack8(t); *(LAS u32x4*)(vbT + i * SQ + 16 * cgp + 8) = pack8(t + 8);
        }
    }
    lds_barrier();
#pragma unroll 1
    for (int id = wave * 4; id < wave * 4 + 4; ++id) {
        const int which = id >> 4, ti = (id & 15) >> 2, tj = id & 3;
        if (tj > ti) {
            if (which == 0) { *(LAS f32x4*)(Mf + (16 * ti + fr) * SM_ + 16 * tj + 4 * fq) = (f32x4){0.f, 0.f, 0.f, 0.f}; }
            else { *(u32x2*)((bf16_t*)(ws + WS_ATTA) + (size_t)item * 4096 + (16 * ti + fr) * 64 + 16 * tj + 4 * fq) = (u32x2){0u, 0u}; }
            continue;
        }
        f32x4 acc = {0.f, 0.f, 0.f, 0.f};
        const LAS bf16_t* ya = which == 0 ? kbs : qs;
#pragma unroll
        for (int k0 = 0; k0 < 128; k0 += 32) acc = MFMA16(lfrag(ks, 16 * tj + fr, SQ, k0, fq), lfrag(ya, 16 * ti + fr, SQ, k0, fq), acc);
        const int ii = 16 * ti + fr, j0 = 16 * tj + 4 * fq;
        const float gi = Gs[ii];
        float o[4];
#pragma unroll
        for (int r = 0; r < 4; ++r) { const int jj = j0 + r; const bool keep = which == 0 ? (ii > jj) : (ii >= jj); o[r] = keep ? acc[r] * __expf(gi - Gs[jj]) : 0.f; }
        if (which == 0) *(LAS f32x4*)(Mf + ii * SM_ + j0) = (f32x4){o[0], o[1], o[2], o[3]};
        else { u32x2 w; w.x = pk2(o[0], o[1]); w.y = pk2(o[2], o[3]); *(u32x2*)((bf16_t*)(ws + WS_ATTA) + (size_t)item * 4096 + ii * 64 + j0) = w; }
    }
    lds_barrier();
    if (tid < 64) {
        const int blk = tid >> 4, j = tid & 15; float x[16];
#pragma unroll
        for (int r = 0; r < 16; ++r) {
            float s = (r == j) ? 1.f : 0.f;
#pragma unroll
            for (int m4 = 0; m4 < 4; ++m4) if (4 * m4 < r) { const f32x4 mv = *(const LAS f32x4*)(Mf + (16 * blk + r) * SM_ + 16 * blk + 4 * m4);
                if (4 * m4 < r) s -= mv.x * x[4 * m4]; if (4 * m4 + 1 < r) s -= mv.y * x[4 * m4 + 1]; if (4 * m4 + 2 < r) s -= mv.z * x[4 * m4 + 2]; if (4 * m4 + 3 < r) s -= mv.w * x[4 * m4 + 3]; }
            x[r] = s;
            asm volatile("" ::: "memory");
        }
#pragma unroll
        for (int r = 0; r < 16; ++r) Tf[(16 * blk + r) * SM_ + 16 * blk + j] = x[r];
    }
    lds_barrier();
#pragma unroll 1
    for (int dlev = 1; dlev < 4; ++dlev)
#pragma unroll 1
        for (int b0 = 0; b0 < 4 - dlev; b0 += 2) {
            const int half = tid >> 8, bj = b0 + half, bi = dlev + bj; const bool active = bj < 4 - dlev;
            const int t2 = tid & 255, r = t2 >> 4, cc = t2 & 15; LAS float* Pf2 = Pf + half * 272;
            if (active) {
                float s = 0.f;
#pragma unroll 1
                for (int kb = bj; kb < bi; ++kb)
#pragma unroll
                    for (int m4 = 0; m4 < 4; ++m4) { const f32x4 mv = *(const LAS f32x4*)(Mf + (16 * bi + r) * SM_ + 16 * kb + 4 * m4);
                        s += mv.x * Tf[(16 * kb + 4 * m4) * SM_ + 16 * bj + cc] + mv.y * Tf[(16 * kb + 4 * m4 + 1) * SM_ + 16 * bj + cc]
                           + mv.z * Tf[(16 * kb + 4 * m4 + 2) * SM_ + 16 * bj + cc] + mv.w * Tf[(16 * kb + 4 * m4 + 3) * SM_ + 16 * bj + cc]; }
                Pf2[r * 17 + cc] = s;
            }
            lds_barrier();
            if (active) {
                float s = 0.f;
#pragma unroll
                for (int m4 = 0; m4 < 4; ++m4) { const f32x4 tv = *(const LAS f32x4*)(Tf + (16 * bi + r) * SM_ + 16 * bi + 4 * m4);
                    s += tv.x * Pf2[(4 * m4) * 17 + cc] + tv.y * Pf2[(4 * m4 + 1) * 17 + cc] + tv.z * Pf2[(4 * m4 + 2) * 17 + cc] + tv.w * Pf2[(4 * m4 + 3) * 17 + cc]; }
                Tf[(16 * bi + r) * SM_ + 16 * bj + cc] = -s;
            }
            lds_barrier();
        }
    {
        const int r = tid >> 3, c0 = (tid & 7) * 8; float t[8];
#pragma unroll
        for (int e = 0; e < 8; ++e) { const int cc = c0 + e; t[e] = ((cc >> 4) <= (r >> 4)) ? Tf[r * SM_ + cc] : 0.f; if ((cc >> 4) == (r >> 4) && cc > r) t[e] = 0.f; }
        *(LAS u32x4*)(Tb + r * SK + c0) = pack8(t);
    }
    lds_barrier();
#pragma unroll 1
    for (int id = wave * 8; id < wave * 8 + 8; ++id) {
        const int which = id >> 5, ti = (id & 31) >> 3, te = id & 7;
        const LAS bf16_t* xa = which == 0 ? vbT : kgT;
        f32x4 acc = {0.f, 0.f, 0.f, 0.f};
#pragma unroll
        for (int k0 = 0; k0 < 64; k0 += 32) acc = MFMA16(trfrag(xa, SQ, k0, 16 * te, fr, fq), lfrag(Tb, 16 * ti + fr, SK, k0, fq), acc);
        const int ri = prow(b, c, 16 * ti + fr);
        if (ri >= 0) { u32x2 w; w.x = pk2(acc[0], acc[1]); w.y = pk2(acc[2], acc[3]);
            *(u32x2*)((bf16_t*)(ws + (which == 0 ? WS_UU : WS_WW)) + (size_t)ri * 512 + h * 128 + 16 * te + 4 * fq) = w; }
    }
    lds_barrier();
}

__device__ __forceinline__ void p2_gla_item(const Params& p, LAS unsigned char* lds, int item) {
    int tid_ = threadIdx.x; asm volatile("" : "+v"(tid_));
    const int tid = tid_, lane = tid & 63, wave = tid >> 6, fr = lane & 15, fq = lane >> 4;
    const int c = item % NCH, bh = item / NCH, h = bh & 3, b = bh >> 2;
    unsigned char* ws = p.ws;
    bf16_t* PA = (bf16_t*)(ws + WS_PROJA);
    const float* SMALL = (const float*)((unsigned char*)p.out + DS_SMALL);
    LAS bf16_t* qs = (LAS bf16_t*)(lds + L_QS); LAS bf16_t* ks = (LAS bf16_t*)(lds + L_KS);
    const int i = lane, row = prow(b, c, i), d0 = 16 * wave;
    LAS float* W2s = (LAS float*)(lds + L_MF);
    f32x4 lrv[4]; u32x4 qraw[2], kraw[2];
    if (row >= 0) {
        const f32x4* lp = (const f32x4*)(SMALL + (size_t)row * 32 + 8);
#pragma unroll
        for (int j = 0; j < 4; ++j) lrv[j] = lp[j];
        const u32x4* qp = (const u32x4*)(PA + (size_t)row * LDA_ + 1536 + h * 128 + d0);
        qraw[0] = qp[0]; qraw[1] = qp[1]; qraw[0] = qp[0]; kraw[0] = qp[64]; kraw[1] = qp[65];
    }
    {
        float wv[4];
#pragma unroll
        for (int u = 0; u < 4; ++u) { const int e = tid + u * NTHR; wv[u] = p.in[I_WGK2][(e >> 7) * 512 + h * 128 + (e & 127)]; }
        const float bv = tid < 128 ? p.in[I_BGK][h * 128 + tid] : 0.f;
#pragma unroll
        for (int u = 0; u < 4; ++u) W2s[tid + u * NTHR] = wv[u];
        if (tid < 128) W2s[2048 + tid] = bv;
    }
    lds_barrier();
    float bc[16];
    if (row >= 0) {
        float lr[16];
#pragma unroll
        for (int j = 0; j < 4; ++j) { const f32x4 t = lrv[j]; lr[4 * j] = t.x; lr[4 * j + 1] = t.y; lr[4 * j + 2] = t.z; lr[4 * j + 3] = t.w; }
#pragma unroll
        for (int e = 0; e < 16; ++e) bc[e] = W2s[2048 + d0 + e];
#pragma unroll
        for (int r = 0; r < 16; ++r) {
#pragma unroll
            for (int e4 = 0; e4 < 4; ++e4) { const f32x4 w = *(const LAS f32x4*)(W2s + r * 128 + d0 + 4 * e4);
                bc[4 * e4] += lr[r] * w.x; bc[4 * e4 + 1] += lr[r] * w.y; bc[4 * e4 + 2] += lr[r] * w.z; bc[4 * e4 + 3] += lr[r] * w.w; }
        }
#pragma unroll
        for (int e = 0; e < 16; ++e) bc[e] = -softplusf_(-bc[e]) * (1.f / 16.f);
    } else {
#pragma unroll
        for (int e = 0; e < 16; ++e) bc[e] = 0.f;
    }
#pragma unroll
    for (int e = 0; e < 16; ++e) bc[e] = wave_incl_scan(bc[e]);
    if (lane == 63) { float* eb = (float*)((unsigned char*)p.out + DS_EBL) + (size_t)item * 128 + d0;
#pragma unroll
        for (int e = 0; e < 16; ++e) eb[e] = __expf(bc[e]); }
    float qv[16], kv[16];
    if (row >= 0) {
        unpack8(qraw[0], qv); unpack8(qraw[1], qv + 8); unpack8(kraw[0], kv); unpack8(kraw[1], kv + 8);
#pragma unroll
        for (int e = 0; e < 16; ++e) { qv[e] *= __expf(bc[e]) * 0.08838834764831845f; kv[e] *= __expf(-bc[e]); }
        u32x4* qp = (u32x4*)(PA + (size_t)row * LDA_ + 1536 + h * 128 + d0);
        qp[0] = pack8(qv); qp[1] = pack8(qv + 8); qp[64] = pack8(kv); qp[65] = pack8(kv + 8);
    } else {
#pragma unroll
        for (int e = 0; e < 16; ++e) { qv[e] = 0.f; kv[e] = 0.f; }
    }
    *(LAS u32x4*)(qs + i * SQ + d0) = pack8(qv); *(LAS u32x4*)(qs + i * SQ + d0 + 8) = pack8(qv + 8);
    *(LAS u32x4*)(ks + i * SQ + d0) = pack8(kv); *(LAS u32x4*)(ks + i * SQ + d0 + 8) = pack8(kv + 8);
    lds_barrier();
    bf16_t* ATT = (bf16_t*)((unsigned char*)p.out + DS_ATTB) + (size_t)item * 4096;
#pragma unroll 1
    for (int id = wave * 2; id < wave * 2 + 2; ++id) {
        const int ti = id >> 2, tj = id & 3;
        const int ii = 16 * ti + fr, j0 = 16 * tj + 4 * fq;
        if (tj > ti) { *(u32x2*)(ATT + ii * 64 + j0) = (u32x2){0u, 0u}; continue; }
        f32x4 acc = {0.f, 0.f, 0.f, 0.f};
#pragma unroll
        for (int k0 = 0; k0 < 128; k0 += 32) acc = MFMA16(lfrag(ks, 16 * tj + fr, SQ, k0, fq), lfrag(qs, 16 * ti + fr, SQ, k0, fq), acc);
        float o[4];
#pragma unroll
        for (int r = 0; r < 4; ++r) o[r] = (ii >= j0 + r) ? acc[r] : 0.f;
        u32x2 w; w.x = pk2(o[0], o[1]); w.y = pk2(o[2], o[3]); *(u32x2*)(ATT + ii * 64 + j0) = w;
    }
    lds_barrier();
}

struct DDPre { float s0, s1, s2, xn, sb, sa; };
__device__ __forceinline__ void dd_load(const Params& p, int item, float (&S)[32], DDPre& q) {
    const int tid = threadIdx.x, n = item >> 2, h = item & 3, row = RDEC0 + n;
    const int e = tid & 127, kq = tid >> 7;
    const float* Sp = p.in[I_SD] + ((size_t)item * 128 + 32 * kq) * 128 + e;
#pragma unroll
    for (int k = 0; k < 32; ++k) S[k] = Sp[(size_t)k * 128];
    const float* SMALL = (const float*)((unsigned char*)p.out + DS_SMALL);
    q.sb = SMALL[(size_t)row * 32 + h]; q.sa = SMALL[(size_t)row * 32 + 4 + h];
    q.s0 = q.s1 = q.s2 = q.xn = 0.f;
    if (tid < 384) {
        const int sel = tid >> 7, chl = tid & 127, ch = sel * 512 + h * 128 + chl;
        const float* st = p.in[I_SDC] + (size_t)n * 3 * CA + ch;
        q.s0 = st[0]; q.s1 = st[CA]; q.s2 = st[2 * CA]; q.xn = bf2f(((const bf16_t*)(p.ws + WS_PROJA))[(size_t)row * LDA_ + ch]);
    }
}
__device__ __forceinline__ void dd_compute(const Params& p, LAS unsigned char* lds, int item, float (&S)[32], const DDPre& q) {
    const int tid = threadIdx.x, lane = tid & 63, wave = tid >> 6;
    const int n = item >> 2, h = item & 3, row = RDEC0 + n;
    LAS float* vals = (LAS float*)lds;
    LAS float* part = vals + 384;
    LAS float* red = part + 8;
    const int e = tid & 127, kq = tid >> 7;
    float y = 0.f;
    if (tid < 384) {
        const int sel = tid >> 7, chl = tid & 127, ch = sel * 512 + h * 128 + chl;
        const float* wc = p.in[I_WCA] + ch;
        y = siluf_(wc[0] * q.s0 + wc[CA] * q.s1 + wc[2 * CA] * q.s2 + wc[3 * CA] * q.xn);
        float* o = p.out + O_DCS + (size_t)n * 3 * CA + ch; o[0] = q.s1; o[CA] = q.s2; o[2 * CA] = q.xn;
        vals[tid] = y;
    }
    const float ws_ = wave_sum(y * y);
    if (lane == 0) part[wave] = ws_;
    lds_barrier();
    const float rq = rsqrtf(part[0] + part[1] + EPS) * 0.08838834764831845f, rk = rsqrtf(part[2] + part[3] + EPS);
    const float beta = sigmoidf_(q.sb);
    const float eg = __expf(-__expf(p.in[I_ALOG][h]) * softplusf_(q.sa + p.in[I_DTB][h]));
    float pe = 0.f;
#pragma unroll
    for (int k = 0; k < 32; ++k) { S[k] *= eg; pe += vals[128 + 32 * kq + k] * rk * S[k]; }
    red[kq * 128 + e] = pe;
    lds_barrier();
    const float err = (vals[256 + e] - (red[e] + red[128 + e] + red[256 + e] + red[384 + e])) * beta;
    lds_barrier();
    float* So = p.out + O_DS + ((size_t)item * 128 + 32 * kq) * 128 + e; float po = 0.f;
#pragma unroll
    for (int k = 0; k < 32; ++k) { const float sv = S[k] + vals[128 + 32 * kq + k] * rk * err; So[(size_t)k * 128] = sv; po += vals[32 * kq + k] * rq * sv; }
    red[kq * 128 + e] = po;
    lds_barrier();
    {
        float* sso = (float*)((unsigned char*)p.out + DS_SSO) + ((size_t)row * 8 + h) * 8;
        float ov = 0.f;
        if (tid < 128) { ov = red[e] + red[128 + e] + red[256 + e] + red[384 + e]; ((bf16_t*)((unsigned char*)p.out + DS_OA))[(size_t)row * 512 + h * 128 + e] = (bf16_t)f2bf(ov); }
        const float sq = wave_sum(ov * ov);
        if (lane == 0) sso[wave] = sq;
    }
    lds_barrier();
}
struct DGPre { float lr, w[16], bg, qx, kx, vx; };
__device__ __forceinline__ void dg_load(const Params& p, int item, float (&S)[64], DGPre& q) {
    const int tid = threadIdx.x, n = item >> 2, h = item & 3, row = RDEC0 + n;
    const int e = tid & 255, kh = tid >> 8;
    const float* Sp = p.in[I_SG] + ((size_t)item * 128 + 64 * kh) * 256 + e;
#pragma unroll
    for (int k = 0; k < 64; ++k) S[k] = Sp[(size_t)k * 256];
    const bf16_t* PA = (const bf16_t*)(p.ws + WS_PROJA);
    q.vx = bf2f(PA[(size_t)row * LDA_ + 2560 + h * 256 + e]);
    q.qx = q.kx = q.bg = 0.f;
    if (tid < 128) { q.qx = bf2f(PA[(size_t)row * LDA_ + 1536 + h * 128 + tid]); q.kx = bf2f(PA[(size_t)row * LDA_ + 2048 + h * 128 + tid]); q.bg = p.in[I_BGK][h * 128 + tid];
#pragma unroll
        for (int r = 0; r < 16; ++r) q.w[r] = p.in[I_WGK2][r * 512 + h * 128 + tid]; }
}
__device__ __forceinline__ void dg_compute(const Params& p, LAS unsigned char* lds, int item, float (&S)[64], const DGPre& q) {
    const int tid = threadIdx.x;
    const int n = item >> 2, h = item & 3, row = RDEC0 + n;
    const float* SMALL = (const float*)((unsigned char*)p.out + DS_SMALL);
    LAS float* qv = (LAS float*)lds; LAS float* kv = qv + 128; LAS float* dv = kv + 128; LAS float* red = dv + 128;
    const int e = tid & 255, kh = tid >> 8;
    if (tid < 128) {
        float x = q.bg;
#pragma unroll
        for (int r = 0; r < 16; ++r) x += SMALL[(size_t)row * 32 + 8 + r] * q.w[r];
        dv[tid] = __expf(-softplusf_(-x) * (1.f / 16.f));
        qv[tid] = q.qx * 0.08838834764831845f;
        kv[tid] = q.kx;
    }
    lds_barrier();
    const float ve = q.vx;
    float* So = p.out + O_GS + ((size_t)item * 128 + 64 * kh) * 256 + e;
    float po = 0.f;
#pragma unroll
    for (int k = 0; k < 64; ++k) { const int kk = 64 * kh + k; const float sv = S[k] * dv[kk] + kv[kk] * ve; So[(size_t)k * 256] = sv; po += qv[kk] * sv; }
    red[kh * 256 + e] = po;
    lds_barrier();
    {
        float* sso = (float*)((unsigned char*)p.out + DS_SSO) + ((size_t)row * 8 + 4 + h) * 8;
        float ov = 0.f;
        if (tid < 256) { ov = red[e] + red[256 + e]; ((bf16_t*)(p.ws + WS_OB))[(size_t)row * 1024 + h * 256 + e] = (bf16_t)f2bf(ov); }
        const float sq = wave_sum(ov * ov);
        if ((tid & 63) == 0) sso[tid >> 6] = sq;
    }
    lds_barrier();
}
__device__ __forceinline__ void p3_decode(const Params& p, LAS unsigned char* lds) {
    const int G = gridDim.x, b0 = blockIdx.x;
    float Sd[32], Sg[64]; DDPre dq; DGPre gq;
    if (G == 256) {
        dd_load(p, b0, Sd, dq); dg_load(p, b0, Sg, gq);
        dd_compute(p, lds, b0, Sd, dq); dd_load(p, b0 + 256, Sd, dq);
        dg_compute(p, lds, b0, Sg, gq); dg_load(p, b0 + 256, Sg, gq);
        dd_compute(p, lds, b0 + 256, Sd, dq);
        dg_compute(p, lds, b0 + 256, Sg, gq);
    } else {
        for (int it = b0; it < NDEC * 4; it += G) { dd_load(p, it, Sd, dq); dd_compute(p, lds, it, Sd, dq); }
        for (int it = b0; it < NDEC * 4; it += G) { dg_load(p, it, Sg, gq); dg_compute(p, lds, it, Sg, gq); }
    }
}

constexpr int LD_WS = 0, LD_QS = LD_WS + 64 * SQ * 2, LD_AS = LD_QS + 64 * SQ * 2, LD_KT = LD_AS + 64 * SK * 2, LD_US = LD_KT + 64 * SQ * 2, LD_BUF = LD_US + 64 * 40 * 2,
              LD_ST = 2 * LD_BUF, LD_VN = LD_ST + 32 * SQ * 2, LD_ENDD = LD_VN + 32 * SK * 2;
static_assert(LD_ENDD <= LDS_BYTES - 64, "delta scan LDS");
struct DReg { u32x4 rw[2], rq[2], rk[2], ra, ru; float egl; };
struct DCtx { const bf16_t *QT, *KT, *WW, *UU, *ATT; const float* EGL; bf16_t* OA; float* SSO; const unsigned char* zero; const float* ones; unsigned char* junk; int b, h, bh, sl, tid, wave, fr, fq; };
__device__ __forceinline__ void delta_prefetch(const DCtx& x, DReg& r, int cc) {
    const bool live = cc < NCH;
    const bf16_t* zp = (const bf16_t*)(x.zero + (x.tid & 255) * 16);
#pragma unroll
    for (int s = 0; s < 2; ++s) { const int pi = x.tid + 512 * s, rr = pi >> 4, c8 = pi & 15; const int gr = live ? prow(x.b, cc, rr) : -1;
        const size_t off = (size_t)(gr >= 0 ? gr : 0) * 512 + x.h * 128 + 8 * c8;
        r.rw[s] = *(const u32x4*)(gr >= 0 ? x.WW + off : zp); r.rq[s] = *(const u32x4*)(gr >= 0 ? x.QT + off : zp); r.rk[s] = *(const u32x4*)(gr >= 0 ? x.KT + off : zp); }
    r.ra = *(const u32x4*)(live ? x.ATT + (size_t)(x.bh * NCH + cc) * 4096 + x.tid * 8 : zp);
    { const int t2 = x.tid & 255, rr = t2 >> 2, c8 = t2 & 3; const int gr = live ? prow(x.b, cc, rr) : -1;
      r.ru = *(const u32x4*)(gr >= 0 ? x.UU + (size_t)gr * 512 + x.h * 128 + 32 * x.sl + 8 * c8 : zp); }
    r.egl = *(live ? x.EGL + x.bh * NCH + cc : x.ones);
}
__device__ __forceinline__ void delta_stage(const DCtx& x, LAS unsigned char* buf, const DReg& r) {
    LAS bf16_t* Wsm = (LAS bf16_t*)(buf + LD_WS); LAS bf16_t* Qsm = (LAS bf16_t*)(buf + LD_QS); LAS bf16_t* Asm = (LAS bf16_t*)(buf + LD_AS);
    LAS bf16_t* KTs = (LAS bf16_t*)(buf + LD_KT); LAS bf16_t* Us = (LAS bf16_t*)(buf + LD_US);
    const int tid = x.tid;
#pragma unroll
    for (int s = 0; s < 2; ++s) { const int pi = tid + 512 * s, rr = pi >> 4, c8 = pi & 15;
        *(LAS u32x4*)(Wsm + rr * SQ + 8 * c8) = r.rw[s]; *(LAS u32x4*)(Qsm + rr * SQ + 8 * c8) = r.rq[s]; *(LAS u32x4*)(KTs + rr * SQ + 8 * c8) = r.rk[s]; }
    *(LAS u32x4*)(Asm + (tid >> 3) * SK + (tid & 7) * 8) = r.ra;
    *(LAS u32x4*)(Us + ((tid & 255) >> 2) * 40 + (tid & 3) * 8) = r.ru;
}
__device__ __forceinline__ void delta_compute(const DCtx& x, LAS unsigned char* lds, LAS unsigned char* buf, int c, float egl, f32x4 (&Sacc)[2]) {
    LAS bf16_t* Wsm = (LAS bf16_t*)(buf + LD_WS); LAS bf16_t* Qsm = (LAS bf16_t*)(buf + LD_QS); LAS bf16_t* Asm = (LAS bf16_t*)(buf + LD_AS);
    LAS bf16_t* KTs = (LAS bf16_t*)(buf + LD_KT); LAS bf16_t* Us = (LAS bf16_t*)(buf + LD_US); LAS bf16_t* St = (LAS bf16_t*)(lds + LD_ST); LAS bf16_t* VnT = (LAS bf16_t*)(lds + LD_VN);
    const int tid = x.tid, wave = x.wave, fr = x.fr, fq = x.fq, it = wave >> 1, et = wave & 1;
    f32x4 av = {0.f, 0.f, 0.f, 0.f}, ao = {0.f, 0.f, 0.f, 0.f};
#pragma unroll
    for (int k0 = 0; k0 < 128; k0 += 32) {
        const bf16x8 sf = lfrag(St, 16 * et + fr, SQ, k0, fq);
        av = MFMA16(lfrag(Wsm, 16 * it + fr, SQ, k0, fq), sf, av);
        ao = MFMA16(sf, lfrag(Qsm, 16 * it + fr, SQ, k0, fq), ao);
    }
    {
        const int ee = 16 * et + fr, i0 = 16 * it + 4 * fq; float vn[4];
#pragma unroll
        for (int q = 0; q < 4; ++q) vn[q] = bf2f(Us[(i0 + q) * 40 + ee]) - av[q];
        u32x2 w; w.x = pk2(vn[0], vn[1]); w.y = pk2(vn[2], vn[3]); *(LAS u32x2*)(VnT + ee * SK + i0) = w;
    }
    lds_barrier();
#pragma unroll
    for (int k0 = 0; k0 < 64; k0 += 32) ao = MFMA16(lfrag(VnT, 16 * et + fr, SK, k0, fq), lfrag(Asm, 16 * it + fr, SK, k0, fq), ao);
    {
        const int gr = c < NCH ? prow(x.b, c, 16 * it + fr) : -1;
        u32x2 w; w.x = pk2(ao[0], ao[1]); w.y = pk2(ao[2], ao[3]);
        *(u32x2*)(gr >= 0 ? (unsigned char*)(x.OA + (size_t)gr * 512 + x.h * 128 + 32 * x.sl + 16 * et + 4 * fq) : x.junk + tid * 8) = w;
        float ss = (ao[0] * ao[0] + ao[1] * ao[1]) + (ao[2] * ao[2] + ao[3] * ao[3]);
        ss += __shfl_xor(ss, 16); ss += __shfl_xor(ss, 32);
        if (fq == 0) *(gr >= 0 ? x.SSO + ((size_t)gr * 8 + x.h) * 8 + 2 * x.sl + et : (float*)(x.junk + tid * 8)) = ss;
    }
#pragma unroll
    for (int t = 0; t < 2; ++t) {
        f32x4 sv = Sacc[t] * egl;
#pragma unroll
        for (int k0 = 0; k0 < 64; k0 += 32) sv = MFMA16(trfrag(KTs, SQ, k0, 16 * wave, fr, fq), lfrag(VnT, 16 * t + fr, SK, k0, fq), sv);
        Sacc[t] = sv;
        u32x2 w; w.x = pk2(sv[0], sv[1]); w.y = pk2(sv[2], sv[3]); *(LAS u32x2*)(St + (16 * t + fr) * SQ + 16 * wave + 4 * fq) = w;
    }
}
__device__ __forceinline__ void p3_scan_delta(const Params& p, LAS unsigned char* lds, int sid) {
    const int tid = threadIdx.x, lane = tid & 63, wave = tid >> 6, fr = lane & 15, fq = lane >> 4;
    const int bh = sid >> 2, sl = sid & 3, h = bh & 3, b = bh >> 2;
    unsigned char* ws = p.ws;
    DCtx x{(const bf16_t*)(ws + WS_QT), (const bf16_t*)(ws + WS_KT), (const bf16_t*)(ws + WS_WW), (const bf16_t*)(ws + WS_UU), (const bf16_t*)(ws + WS_ATTA),
           (const float*)((unsigned char*)p.out + DS_EGL), (bf16_t*)((unsigned char*)p.out + DS_OA), (float*)((unsigned char*)p.out + DS_SSO), ws + WS_ZERO, (const float*)(ws + WS_ONES), ws + WS_JUNK, b, h, bh, sl, tid, wave, fr, fq};
    LAS bf16_t* St = (LAS bf16_t*)(lds + LD_ST);
    for (int e = tid; e < 32 * SQ / 2; e += NTHR) ((LAS unsigned*)St)[e] = 0u;
    f32x4 Sacc[2] = {{0.f, 0.f, 0.f, 0.f}, {0.f, 0.f, 0.f, 0.f}};
    DReg r0, r1;
    delta_prefetch(x, r0, 0); delta_prefetch(x, r1, 1);
    for (int c = 0; c < NCH + 1; c += 2) {
        lds_barrier();
        delta_stage(x, lds, r0); delta_stage(x, lds + LD_BUF, r1);
        const float egl0 = r0.egl, egl1 = r1.egl;
        delta_prefetch(x, r0, c + 2); delta_prefetch(x, r1, c + 3);
        lds_barrier();
        delta_compute(x, lds, lds, c, egl0, Sacc);
        lds_barrier();
        delta_compute(x, lds, lds + LD_BUF, c + 1, egl1, Sacc);
    }
#pragma unroll
    for (int t = 0; t < 2; ++t)
#pragma unroll
        for (int r = 0; r < 4; ++r) p.out[O_DP + ((size_t)bh * 128 + 16 * wave + 4 * fq + r) * 128 + 32 * sl + 16 * t + fr] = Sacc[t][r];
    lds_barrier();
}

constexpr int LG_QS = 0, LG_KT = LG_QS + 64 * SQ * 2, LG_AS = LG_KT + 64 * SQ * 2, LG_VT = LG_AS + 64 * SK * 2, LG_BUF = LG_VT + 64 * SK * 2, LG_ST = 2 * LG_BUF, LG_END = LG_ST + 64 * SQ * 2;
static_assert(LG_END <= LDS_BYTES - 64, "gla scan LDS");
struct GReg { u32x4 rq[2], rk[2], ra, rv; f32x4 dd; };
struct GCtx { const bf16_t *PA, *ATT; const float* EBL; bf16_t* OB; float* SSO; const unsigned char* zero; const float* ones; unsigned char* junk; int b, h, bh, sl, tid, wave, fr, fq; };
__device__ __forceinline__ void gla_prefetch(const GCtx& x, GReg& r, int cc) {
    const bool live = cc < NCH;
    const bf16_t* zp = (const bf16_t*)(x.zero + (x.tid & 255) * 16);
#pragma unroll
    for (int s = 0; s < 2; ++s) { const int pi = x.tid + 512 * s, rr = pi >> 4, c8 = pi & 15; const int gr = live ? prow(x.b, cc, rr) : -1;
        const size_t off = (size_t)(gr >= 0 ? gr : 0) * LDA_ + x.h * 128 + 8 * c8;
        r.rq[s] = *(const u32x4*)(gr >= 0 ? x.PA + off + 1536 : zp); r.rk[s] = *(const u32x4*)(gr >= 0 ? x.PA + off + 2048 : zp); }
    r.ra = *(const u32x4*)(live ? x.ATT + (size_t)(x.bh * NCH + cc) * 4096 + x.tid * 8 : zp);
    { const int rr = x.tid >> 3, c8 = x.tid & 7; const int gr = live ? prow(x.b, cc, rr) : -1;
      r.rv = *(const u32x4*)(gr >= 0 ? x.PA + (size_t)gr * LDA_ + 2560 + x.h * 256 + 64 * x.sl + 8 * c8 : zp); }
    r.dd = *(const f32x4*)(live ? x.EBL + (size_t)(x.bh * NCH + cc) * 128 + 16 * x.wave + 4 * x.fq : x.ones);
}
__device__ __forceinline__ void gla_stage(const GCtx& x, LAS unsigned char* buf, const GReg& r) {
    LAS bf16_t* Qsm = (LAS bf16_t*)(buf + LG_QS); LAS bf16_t* KTs = (LAS bf16_t*)(buf + LG_KT); LAS bf16_t* Asm = (LAS bf16_t*)(buf + LG_AS); LAS bf16_t* VT = (LAS bf16_t*)(buf + LG_VT);
    const int tid = x.tid;
#pragma unroll
    for (int s = 0; s < 2; ++s) { const int pi = tid + 512 * s, rr = pi >> 4, c8 = pi & 15;
        *(LAS u32x4*)(Qsm + rr * SQ + 8 * c8) = r.rq[s]; *(LAS u32x4*)(KTs + rr * SQ + 8 * c8) = r.rk[s]; }
    *(LAS u32x4*)(Asm + (tid >> 3) * SK + (tid & 7) * 8) = r.ra;
    *(LAS u32x4*)(VT + (tid >> 3) * SK + (tid & 7) * 8) = r.rv;
}
__device__ __forceinline__ void gla_compute(const GCtx& x, LAS unsigned char* lds, LAS unsigned char* buf, int c, f32x4 dd, f32x4 (&Sacc)[4]) {
    LAS bf16_t* Qsm = (LAS bf16_t*)(buf + LG_QS); LAS bf16_t* KTs = (LAS bf16_t*)(buf + LG_KT); LAS bf16_t* Asm = (LAS bf16_t*)(buf + LG_AS);
    LAS bf16_t* VT = (LAS bf16_t*)(buf + LG_VT); LAS bf16_t* St = (LAS bf16_t*)(lds + LG_ST);
    const int tid = x.tid, wave = x.wave, fr = x.fr, fq = x.fq, it = wave >> 1, eh = wave & 1;
    const int gr = c < NCH ? prow(x.b, c, 16 * it + fr) : -1;
    float ssq = 0.f;
#pragma unroll
    for (int t = 0; t < 2; ++t) {
        const int et = 2 * eh + t;
        f32x4 ao = {0.f, 0.f, 0.f, 0.f};
#pragma unroll
        for (int k0 = 0; k0 < 128; k0 += 32) ao = MFMA16(lfrag(St, 16 * et + fr, SQ, k0, fq), lfrag(Qsm, 16 * it + fr, SQ, k0, fq), ao);
#pragma unroll
        for (int k0 = 0; k0 < 64; k0 += 32) ao = MFMA16(trfrag(VT, SK, k0, 16 * et, fr, fq), lfrag(Asm, 16 * it + fr, SK, k0, fq), ao);
        { u32x2 w; w.x = pk2(ao[0], ao[1]); w.y = pk2(ao[2], ao[3]); *(u32x2*)(gr >= 0 ? (unsigned char*)(x.OB + (size_t)gr * 1024 + x.h * 256 + 64 * x.sl + 16 * et + 4 * fq) : x.junk + tid * 8) = w; }
        ssq += (ao[0] * ao[0] + ao[1] * ao[1]) + (ao[2] * ao[2] + ao[3] * ao[3]);
    }
    ssq += __shfl_xor(ssq, 16); ssq += __shfl_xor(ssq, 32);
    if (fq == 0) *(gr >= 0 ? x.SSO + ((size_t)gr * 8 + 4 + x.h) * 8 + 2 * x.sl + eh : (float*)(x.junk + tid * 8)) = ssq;
#pragma unroll
    for (int t = 0; t < 4; ++t) {
        f32x4 sv = Sacc[t];
#pragma unroll
        for (int k0 = 0; k0 < 64; k0 += 32) sv = MFMA16(trfrag(KTs, SQ, k0, 16 * wave, fr, fq), trfrag(VT, SK, k0, 16 * t, fr, fq), sv);
        Sacc[t] = sv * dd;
    }
    lds_barrier();
#pragma unroll
    for (int t = 0; t < 4; ++t) { u32x2 w; w.x = pk2(Sacc[t][0], Sacc[t][1]); w.y = pk2(Sacc[t][2], Sacc[t][3]); *(LAS u32x2*)(St + (16 * t + fr) * SQ + 16 * wave + 4 * fq) = w; }
}
__device__ __forceinline__ void p3_scan_gla(const Params& p, LAS unsigned char* lds, int sid) {
    const int tid = threadIdx.x, lane = tid & 63, wave = tid >> 6, fr = lane & 15, fq = lane >> 4;
    const int bh = sid >> 2, sl = sid & 3, h = bh & 3, b = bh >> 2;
    GCtx x{(const bf16_t*)(p.ws + WS_PROJA), (const bf16_t*)((unsigned char*)p.out + DS_ATTB), (const float*)((unsigned char*)p.out + DS_EBL), (bf16_t*)(p.ws + WS_OB), (float*)((unsigned char*)p.out + DS_SSO), p.ws + WS_ZERO, (const float*)(p.ws + WS_ONES), p.ws + WS_JUNK, b, h, bh, sl, tid, wave, fr, fq};
    LAS bf16_t* St = (LAS bf16_t*)(lds + LG_ST);
    for (int e = tid; e < 64 * SQ / 2; e += NTHR) ((LAS unsigned*)St)[e] = 0u;
    f32x4 Sacc[4];
#pragma unroll
    for (int t = 0; t < 4; ++t) Sacc[t] = (f32x4){0.f, 0.f, 0.f, 0.f};
    GReg r0, r1;
    gla_prefetch(x, r0, 0); gla_prefetch(x, r1, 1);
    for (int c = 0; c < NCH + 1; c += 2) {
        lds_barrier();
        gla_stage(x, lds, r0); gla_stage(x, lds + LG_BUF, r1);
        const f32x4 dd0 = r0.dd, dd1 = r1.dd;
        gla_prefetch(x, r0, c + 2); gla_prefetch(x, r1, c + 3);
        lds_barrier();
        gla_compute(x, lds, lds, c, dd0, Sacc);
        lds_barrier();
        gla_compute(x, lds, lds + LG_BUF, c + 1, dd1, Sacc);
    }
#pragma unroll
    for (int t = 0; t < 4; ++t)
#pragma unroll
        for (int r = 0; r < 4; ++r) p.out[O_GP + ((size_t)bh * 128 + 16 * wave + 4 * fq + r) * 256 + 64 * sl + 16 * t + fr] = Sacc[t][r];
    lds_barrier();
}

__device__ __forceinline__ void p_gate(const Params& p) {
    const int tid = threadIdx.x, lane = tid & 63, wave = tid >> 6;
    const int gw = blockIdx.x * 8 + wave, NGW = gridDim.x * 8;
    bf16_t* OA = (bf16_t*)((unsigned char*)p.out + DS_OA); bf16_t* OB = (bf16_t*)(p.ws + WS_OB); const bf16_t* Z = (const bf16_t*)(p.ws + WS_Z);
    for (int row0 = gw; row0 < R; row0 += 2 * NGW) {
        u32x4 oa[2], za[2], ob[2][2], zb[2][2];
#pragma unroll
        for (int u = 0; u < 2; ++u) { const int row = row0 + u * NGW; if (row < R) {
            oa[u] = *(const u32x4*)(OA + (size_t)row * 512 + 8 * lane); za[u] = *(const u32x4*)(Z + (size_t)row * 1536 + 8 * lane);
            const u32x4* op = (const u32x4*)(OB + (size_t)row * 1024 + 16 * lane); const u32x4* zp = (const u32x4*)(Z + (size_t)row * 1536 + 512 + 16 * lane);
            ob[u][0] = op[0]; ob[u][1] = op[1]; zb[u][0] = zp[0]; zb[u][1] = zp[1]; } }
#pragma unroll
        for (int u = 0; u < 2; ++u) { const int row = row0 + u * NGW; if (row < R) {
            {
                float o[8], z[8]; unpack8(oa[u], o); unpack8(za[u], z);
                float s = 0.f;
#pragma unroll
                for (int e = 0; e < 8; ++e) s += o[e] * o[e];
                s += __shfl_xor(s, 1); s += __shfl_xor(s, 2); s += __shfl_xor(s, 4); s += __shfl_xor(s, 8);
                const float rs = rsqrtf(s * (1.f / 128.f) + EPS); const float* nw = p.in[I_ONA] + 8 * (lane & 15);
#pragma unroll
                for (int e = 0; e < 8; ++e) o[e] = o[e] * rs * nw[e] * siluf_(z[e]);
                *(u32x4*)(OA + (size_t)row * 512 + 8 * lane) = pack8(o);
            }
            {
                float o[16], z[16]; unpack8(ob[u][0], o); unpack8(ob[u][1], o + 8); unpack8(zb[u][0], z); unpack8(zb[u][1], z + 8);
                float s = 0.f;
#pragma unroll
                for (int e = 0; e < 16; ++e) s += o[e] * o[e];
                s += __shfl_xor(s, 1); s += __shfl_xor(s, 2); s += __shfl_xor(s, 4); s += __shfl_xor(s, 8);
                const float rs = rsqrtf(s * (1.f / 256.f) + EPS); const float* nw = p.in[I_ONB] + 16 * (lane & 15);
#pragma unroll
                for (int e = 0; e < 16; ++e) o[e] = o[e] * rs * nw[e] * siluf_(z[e]);
                u32x4* op = (u32x4*)(OB + (size_t)row * 1024 + 16 * lane); op[0] = pack8(o); op[1] = pack8(o + 8);
            }
        } }
    }
}
__device__ __forceinline__ void p_act(const Params& p) {
    const bf16_t* U = (const bf16_t*)(p.ws + WS_U); bf16_t* GF = (bf16_t*)(p.ws + WS_GF);
    const float* wf = p.in[I_WCF]; const float* bfc = p.in[I_BCF];
    const int gt = blockIdx.x * NTHR + threadIdx.x, NGT = gridDim.x * NTHR;
    constexpr int NC8 = DFF / 8, NSTRIP = RP / 8;
    for (int wi = gt; wi < (NSTRIP + NDEC) * NC8; wi += NGT) {
        const int c8 = wi % NC8, st = wi / NC8, col = 8 * c8;
        float w0[8], w1[8], w2[8], bb[8];
        {
            const f32x4 a0 = *(const f32x4*)(wf + col), a1 = *(const f32x4*)(wf + col + 4), b0 = *(const f32x4*)(wf + DFF + col), b1 = *(const f32x4*)(wf + DFF + col + 4);
            const f32x4 c0 = *(const f32x4*)(wf + 2 * DFF + col), c1 = *(const f32x4*)(wf + 2 * DFF + col + 4), d0 = *(const f32x4*)(bfc + col), d1 = *(const f32x4*)(bfc + col + 4);
#pragma unroll
            for (int e = 0; e < 4; ++e) { w0[e] = a0[e]; w0[4 + e] = a1[e]; w1[e] = b0[e]; w1[4 + e] = b1[e]; w2[e] = c0[e]; w2[4 + e] = c1[e]; bb[e] = d0[e]; bb[4 + e] = d1[e]; }
        }
        if (st < NSTRIP) {
            const int r0 = st * 8; float p2[8], p1[8];
            int ra = -1, rb = -1;
            if (r0 < RMAIN) { if ((r0 & (SEQ - 1)) == 0) { const int b = r0 / SEQ; ra = RMETA0 + b * 16 + 14; rb = ra + 1; } else { ra = r0 - 2; rb = r0 - 1; } }
            else if (((r0 - RMETA0) & 15) != 0) { ra = r0 - 2; rb = r0 - 1; }
            if (ra >= 0) { unpack8(*(const u32x4*)(U + (size_t)ra * DFF + col), p2); unpack8(*(const u32x4*)(U + (size_t)rb * DFF + col), p1); }
            else {
#pragma unroll
                for (int e = 0; e < 8; ++e) { p2[e] = 0.f; p1[e] = 0.f; } }
            for (int rr = 0; rr < 8; rr += 8) {
                u32x4 ur[8], gr[8];
#pragma unroll
                for (int q = 0; q < 8; ++q) { ur[q] = *(const u32x4*)(U + (size_t)(r0 + rr + q) * DFF + col); gr[q] = *(const u32x4*)(GF + (size_t)(r0 + rr + q) * DFF + col); }
#pragma unroll
                for (int q = 0; q < 8; ++q) {
                    const int row = r0 + rr + q; float u[8], g[8], o[8];
                    unpack8(ur[q], u); unpack8(gr[q], g);
#pragma unroll
                    for (int e = 0; e < 8; ++e) { o[e] = gelu_tanh(w0[e] * p2[e] + w1[e] * p1[e] + w2[e] * u[e] + bb[e]) * g[e]; p2[e] = p1[e]; p1[e] = u[e]; }
                    *(u32x4*)(GF + (size_t)row * DFF + col) = pack8(o);
                    if (row < RMAIN && (row & (SEQ - 1)) >= SEQ - 2) { float* so = p.out + O_FCP + ((size_t)(row / SEQ) * 2 + ((row & (SEQ - 1)) - (SEQ - 2))) * DFF + col;
#pragma unroll
                        for (int e = 0; e < 8; ++e) so[e] = u[e]; }
                }
            }
        } else {
            const int n = st - NSTRIP, row = RDEC0 + n; float u[8], g[8], o[8];
            const float* s0 = p.in[I_SFC] + (size_t)n * 2 * DFF + col; const float* s1 = s0 + DFF;
            unpack8(*(const u32x4*)(U + (size_t)row * DFF + col), u); unpack8(*(const u32x4*)(GF + (size_t)row * DFF + col), g);
            float* so = p.out + O_FCS + (size_t)n * 2 * DFF + col;
#pragma unroll
            for (int e = 0; e < 8; ++e) { o[e] = gelu_tanh(w0[e] * s0[e] + w1[e] * s1[e] + w2[e] * u[e] + bb[e]) * g[e]; so[e] = s1[e]; so[DFF + e] = u[e]; }
            *(u32x4*)(GF + (size_t)row * DFF + col) = pack8(o);
        }
    }
}
__device__ __forceinline__ void p_final(const Params& p) {
    const float* SS3 = (const float*)(p.ws + WS_SS3); const float* nw = p.in[I_NFIN];
    const int gt = blockIdx.x * NTHR + threadIdx.x, NGT = gridDim.x * NTHR;
    constexpr int NIT = (RMAIN + NDEC) * 256;
    for (int w0 = gt; w0 < NIT; w0 += 8 * NGT) {
        f32x4 v[8]; f32x4* o[8]; float rs[8];
#pragma unroll
        for (int u = 0; u < 8; ++u) { const int wi = w0 + u * NGT; if (wi < NIT) { int row = wi >> 8; if (row >= RMAIN) row += (RDEC0 - RMAIN); o[u] = (f32x4*)(p.out + yslot(row)) + (wi & 255); v[u] = *o[u]; rs[u] = SS3[row]; } }
#pragma unroll
        for (int u = 0; u < 8; ++u) { const int wi = w0 + u * NGT; if (wi < NIT) { const float r = rsqrtf(rs[u] * (1.f / D) + EPS); const f32x4 w = ((const f32x4*)nw)[wi & 255];
            f32x4 t = v[u]; t.x *= r * w.x; t.y *= r * w.y; t.z *= r * w.z; t.w *= r * w.w; *o[u] = t; } }
    }
}

#define XB_TMO      128
#define XB_XCNT(j)  (256  + 64 * (j))
#define XB_XSUB(j)  (1280 + 64 * (j))
#define XB_XGEN(j)  (2304 + 64 * (j))
#define XB_TOP      3328
#define XB_TOPGEN   3392
#define XCD_BAR_WORDS 3456
#define XB_SPIN_CAP (1u << 18)

__device__ __forceinline__ unsigned xb_ld(unsigned* p)              { return __hip_atomic_load(p, __ATOMIC_RELAXED, __HIP_MEMORY_SCOPE_AGENT); }
__device__ __forceinline__ unsigned xb_add(unsigned* p, unsigned v) { return __hip_atomic_fetch_add(p, v, __ATOMIC_RELAXED, __HIP_MEMORY_SCOPE_AGENT); }
__device__ __forceinline__ unsigned xb_xcc_id() { return (unsigned)__builtin_amdgcn_s_getreg((3 << 11) | 20) & 0xFu; }
#define XB_SPIN(cond, bar) do { unsigned _sp = 0; while (cond) { __builtin_amdgcn_s_sleep(1); \
    if ((++_sp & 255u) == 0u) { if (xb_ld(&(bar)[XB_TMO])) break; if (_sp > XB_SPIN_CAP) { atomicAdd(&(bar)[XB_TMO], 1u); break; } } } } while (0)

struct XcdBarrier {
    unsigned* bar; unsigned x;
    volatile LAS unsigned* st;
};

__device__ __forceinline__ XcdBarrier xcd_barrier_post(unsigned* bar, volatile LAS unsigned* st) {
    XcdBarrier b; b.bar = bar; b.x = xb_xcc_id(); b.st = st;
    if (threadIdx.x == 0) (void)xb_add(&bar[XB_XCNT(b.x)], 1u);
    return b;
}
__device__ __forceinline__ void xcd_barrier_complete(unsigned* bar, unsigned x, unsigned& nloc, unsigned& nx) {
    const unsigned G = gridDim.x * gridDim.y * gridDim.z;
    unsigned sum, cnt, mine, sp = 0u;
    for (;;) {
        sum = 0u; cnt = 0u; mine = 0u;
#pragma unroll
        for (unsigned j = 0; j < 16; ++j) { const unsigned c = xb_ld(&bar[XB_XCNT(j)]); sum += c; cnt += (c > 0u) ? 1u : 0u; mine = (j == x) ? c : mine; }
        if (sum == G) break;
        __builtin_amdgcn_s_sleep(1);
        if ((++sp & 255u) == 0u) { if (xb_ld(&bar[XB_TMO])) break; if (sp > XB_SPIN_CAP) { atomicAdd(&bar[XB_TMO], 1u); break; } }
    }
    nloc = mine > 0u ? mine : 1u; nx = cnt > 0u ? cnt : 1u;
}

__device__ __forceinline__ void xcd_barrier(const XcdBarrier& b) {
    asm volatile("s_waitcnt vmcnt(0)" ::: "memory");
    __syncthreads();
    if (threadIdx.x == 0) {
        unsigned* bar = b.bar;
        __builtin_amdgcn_s_waitcnt(0);
        unsigned nloc = b.st[0], nx = b.st[1];
        if (nloc == 0u) { xcd_barrier_complete(bar, b.x, nloc, nx); b.st[0] = nloc; b.st[1] = nx; }
        const unsigned old = xb_add(&bar[XB_XSUB(b.x)], 1u);
        const unsigned gen = old / nloc;
        if (old + 1u == (gen + 1u) * nloc) {
            __builtin_amdgcn_fence(__ATOMIC_RELEASE, "agent");
            asm volatile("s_waitcnt vmcnt(0)" ::: "memory");
            const unsigned og = xb_add(&bar[XB_TOP], 1u);
            const unsigned tg = og / nx;
            if (og + 1u == (tg + 1u) * nx) xb_add(&bar[XB_TOPGEN], 1u);
            else XB_SPIN(xb_ld(&bar[XB_TOPGEN]) == tg, bar);
            __builtin_amdgcn_fence(__ATOMIC_ACQUIRE, "agent");
            xb_add(&bar[XB_XGEN(b.x)], 1u);
            asm volatile("s_waitcnt vmcnt(0)" ::: "memory");
        } else {
            XB_SPIN(xb_ld(&bar[XB_XGEN(b.x)]) == gen, bar);
            __builtin_amdgcn_fence(__ATOMIC_ACQUIRE, "agent");
            asm volatile("s_waitcnt vmcnt(0)" ::: "memory");
        }
    }
    __syncthreads();
}


constexpr int NPHASE = 12;
#ifndef PROBE_MASK
#define PROBE_MASK 0
#endif
#define REPS(k) for (int rep_ = 0; rep_ <= ((PROBE_MASK >> (k)) & 1); ++rep_)
__global__ void __launch_bounds__(NTHR, 2) fwd_kernel(Params p) {
    extern __shared__ __attribute__((aligned(16))) unsigned char lds_raw[];
    LAS unsigned char* lds = (LAS unsigned char*)lds_raw;
    cg::grid_group grid = cg::this_grid();
    volatile LAS unsigned* bst = (volatile LAS unsigned*)(lds + LDS_BYTES - 64);
    if (threadIdx.x == 0) { bst[0] = 0u; bst[1] = 0u; }
    __syncthreads();
    XcdBarrier bar; bar.bar = (unsigned*)(p.ws + WS_BAR); bar.x = 0; bar.st = bst;
    if (p.ph_hi - p.ph_lo > 1 && blockIdx.x == 0) for (int e = threadIdx.x; e < XCD_BAR_WORDS; e += NTHR) __hip_atomic_store((unsigned*)(p.ws + WS_BAR) + e, 0u, __ATOMIC_RELAXED, __HIP_MEMORY_SCOPE_AGENT);
    unsigned char* ws = p.ws; unsigned char* ob = (unsigned char*)p.out;
    const int lo = p.ph_lo, hi = p.ph_hi, G = gridDim.x;
#define IN(k) (lo <= (k) && (k) < hi)
#ifdef PROBE_TS_MASK
    unsigned long long ts_[NPHASE + 1]; ts_[0] = __builtin_amdgcn_s_memrealtime();
#ifdef PROBE_TX
    unsigned long long tx_[4] = {0, 0, 0, 0};
#endif
#define SEAM(k) do { if (IN(k) && IN((k) + 1)) xcd_barrier(bar); ts_[(k) + 1] = __builtin_amdgcn_s_memrealtime(); } while (0)
#else
#define SEAM(k) do { if (IN(k) && IN((k) + 1)) xcd_barrier(bar); } while (0)
#endif
    if (IN(0)) REPS(0) { p0_prologue(p, lds); }
    if (IN(0) && IN(1)) { __threadfence(); grid.sync(); bar = xcd_barrier_post((unsigned*)(p.ws + WS_BAR), bst); }
#ifdef PROBE_TS_MASK
    ts_[1] = __builtin_amdgcn_s_memrealtime();
#endif
#ifdef PROBE_XSYNC
    for (int i = 0; i < PROBE_XSYNC; ++i) xcd_barrier(bar);
#endif
    if (IN(1)) REPS(1) {
        pg8::Gemm g{(const bf16_t*)(ob + DS_HN), (const bf16_t*)(ws + WS_WTA), R, NA, 1024}; pg8::StaticOrder S; S.init(R, NA, G, (int)blockIdx.x);
        pg8::Epi8<FA> E{FA{(bf16_t*)(ws + WS_PROJA), (float*)(ob + DS_SMALL)}};
        pg8::gemm_phase<pg8::Epi8<FA>, pg8::StaticOrder, true, true>(lds, g, S, E);
        transposes_in_idle_slots<6, 9>(p, lds, (R / 256) * (NA / 256));
    }
    SEAM(1);
    if (IN(2)) REPS(2) {
#ifdef PROBE_TX
        bool st_ = false;
#endif
        for (int it = blockIdx.x; it < 2 * NITEM; it += G) {
#ifdef PROBE_TX
            if (it >= NITEM && !st_) { st_ = true; tx_[0] = __builtin_amdgcn_s_memrealtime(); }
#endif
            if (it < NITEM) p2_delta_item(p, lds, it); else p2_gla_item(p, lds, it - NITEM); }
#ifdef PROBE_TX
        tx_[1] = __builtin_amdgcn_s_memrealtime();
#endif
    }
    SEAM(2);
    if (IN(3)) REPS(3) {
        p3_decode(p, lds);
#ifdef PROBE_TX
        tx_[2] = __builtin_amdgcn_s_memrealtime();
#endif
        const int vb = (G % 8 == 0) ? (int)(blockIdx.x % 8) * (G / 8) + (int)blockIdx.x / 8 : (int)blockIdx.x;
        for (int sid = vb; sid < 256; sid += G) { if (sid < 128) p3_scan_delta(p, lds, sid); else p3_scan_gla(p, lds, sid - 128); }
#ifdef PROBE_TX
        tx_[3] = __builtin_amdgcn_s_memrealtime();
#endif
    }
    SEAM(3);
    if (IN(4)) REPS(4) {
        pg8::Gemm g{(const bf16_t*)(ob + DS_HN), (const bf16_t*)(ws + WS_WTB), R, NBW, 1024}; pg8::StaticOrder S; S.init(R, NBW, G, (int)blockIdx.x);
        pg8::Epi8<FB> E{FB{(bf16_t*)(ob + DS_OA), (bf16_t*)(ws + WS_OB), (const float*)(ob + DS_SSO), p.in[I_ONA], p.in[I_ONB], (bf16_t*)(ws + WS_SG)}};
        pg8::gemm_phase<pg8::Epi8<FB>, pg8::StaticOrder, true, true>(lds, g, S, E);
        transposes_in_idle_slots<9, 11>(p, lds, (R / 256) * (NBW / 256));
    }
    SEAM(4);
    if (IN(6)) REPS(6) {
        {
            pg8::Gemm g{(const bf16_t*)(ob + DS_OA), (const bf16_t*)(ws + WS_WA), RMAIN, 1024, 512}; pg8::StaticOrder S; S.init(RMAIN, 1024, G, (int)blockIdx.x);
            FMix<0> f{(const bf16_t*)(ws + WS_SG), (bf16_t*)(ws + WS_MIX)}; pg8::Epi8<FMix<0>> E{f};
            pg8::gemm_phase<pg8::Epi8<FMix<0>>, pg8::StaticOrder, true, true>(lds, g, S, E);
            thin_gemm(lds, g.A, g.Bt, 512, 1024, RMAIN, f);
        }
        {
            pg8::Gemm g{(const bf16_t*)(ws + WS_OB), (const bf16_t*)(ws + WS_WB), RMAIN, 1024, 1024}; pg8::StaticOrder S; S.init(RMAIN, 1024, G, (int)blockIdx.x);
            FMix<1> f{(const bf16_t*)(ws + WS_SG), (bf16_t*)(ws + WS_MIX)}; pg8::Epi8<FMix<1>> E{f};
            pg8::gemm_phase<pg8::Epi8<FMix<1>>, pg8::StaticOrder, true, true>(lds, g, S, E);
            thin_gemm(lds, g.A, g.Bt, 1024, 1024, RMAIN, f);
        }
    }
    SEAM(6);
    if (IN(7)) REPS(7) {
        pg8::Gemm g{(const bf16_t*)(ws + WS_MIX), (const bf16_t*)(ws + WS_WO), RMAIN, 1024, 1024}; pg8::StaticOrder S; S.init(RMAIN, 1024, G, (int)blockIdx.x);
        FX2 f{p.in[I_XP], p.in[I_META], p.in[I_XS], p.out, p.in[I_NFFN], (bf16_t*)(ws + WS_HN2), (float*)(ws + WS_SS2)}; pg8::Epi8<FX2> E{f};
        pg8::gemm_phase<pg8::Epi8<FX2>, pg8::StaticOrder, true, true>(lds, g, S, E);
        thin_gemm(lds, g.A, g.Bt, 1024, 1024, RMAIN, f);
    }
    SEAM(7);
    if (IN(8)) REPS(8) {
        pg8::Gemm g{(const bf16_t*)(ws + WS_HN2), (const bf16_t*)(ws + WS_WF1), R, 5632, 1024}; pg8::StaticOrder S; S.init(R, 5632, G, (int)blockIdx.x);
        EpiAct E{ws, p.in[I_WCF], p.in[I_BCF]};
        pg8::gemm_phase<EpiAct, pg8::StaticOrder, true, true>(lds, g, S, E);
    }
    SEAM(8);
    if (IN(9)) REPS(9) { p_fix(p); }
    SEAM(9);
    if (IN(10)) REPS(10) {
        pg8::Gemm g{(const bf16_t*)(ws + WS_GF), (const bf16_t*)(ws + WS_WF2), RMAIN, 1024, DFF}; pg8::StaticOrder S; S.init(RMAIN, 1024, G, (int)blockIdx.x);
        FF2 f{p.out, (float*)(ws + WS_SS3)}; pg8::Epi8<FF2> E{f};
        pg8::gemm_phase<pg8::Epi8<FF2>, pg8::StaticOrder, true, true>(lds, g, S, E);
        thin_gemm(lds, g.A, g.Bt, DFF, 1024, RMAIN, f);
    }
    SEAM(10);
    if (IN(11)) REPS(11) { p_final(p); }
#ifdef PROBE_TS_MASK
    ts_[NPHASE] = __builtin_amdgcn_s_memrealtime();
#ifndef PROBE_BLK
#define PROBE_BLK 0
#endif
    if (blockIdx.x == PROBE_BLK) {
        unsigned long long tt = 0;
#pragma unroll
        for (int k = 0; k < NPHASE; ++k) if ((PROBE_TS_MASK >> k) & 1) tt += ts_[k + 1] - ts_[k];
#ifdef PROBE_TX
        if (PROBE_TX == 1) tt = tx_[0] - ts_[2];
        if (PROBE_TX == 2) tt = tx_[1] - tx_[0];
        if (PROBE_TX == 3) tt = tx_[2] - ts_[3];
        if (PROBE_TX == 4) tt = tx_[3] - tx_[2];
#endif
        const float T_us = (float)tt * 0.01f;
        const float sc = 1.f + sqrtf(4e-5f + T_us * 2.5e-7f);
        for (int e = threadIdx.x; e < 36864; e += NTHR) p.out[O_DCP + e] *= sc;
    }
#endif
#undef IN
#undef SEAM
}

#ifndef N_LAUNCH_MODE
#define N_LAUNCH_MODE 1
#endif
extern "C" void kernel_launch(void* const* d_in, const int* in_sizes, int n_in, void* d_out, int out_size, void* d_ws, size_t ws_size, hipStream_t stream) {
    static int grid = 0;
    if (grid == 0) {
        int dev = 0, cus = 0, per_cu = 0;
        hipGetDevice(&dev); hipDeviceGetAttribute(&cus, hipDeviceAttributeMultiprocessorCount, dev);
        hipFuncSetAttribute((const void*)fwd_kernel, hipFuncAttributeMaxDynamicSharedMemorySize, LDS_BYTES);
        hipOccupancyMaxActiveBlocksPerMultiprocessor(&per_cu, (const void*)fwd_kernel, NTHR, LDS_BYTES);
        if (per_cu < 1) { fprintf(stderr, "occupancy query says %d blocks/CU\n", per_cu); per_cu = 1; }
        grid = cus * 1;
        if (n_in != 25 || (size_t)out_size != O_END || ws_size < 256 * MiB) fprintf(stderr, "kernel_launch: unexpected sizes n_in %d out %d ws %zu\n", n_in, out_size, ws_size);
    }
    Params p{};
    for (int i = 0; i < 25; ++i) p.in[i] = (const float*)d_in[i];
    p.out = (float*)d_out; p.ws = (unsigned char*)d_ws;
#if N_LAUNCH_MODE == 1
    p.ph_lo = 0; p.ph_hi = NPHASE;
    void* args[] = {&p};
    hipError_t e = hipLaunchCooperativeKernel((const void*)fwd_kernel, dim3(grid), dim3(NTHR), args, LDS_BYTES, stream);
    if (e != hipSuccess) fprintf(stderr, "cooperative launch failed: %s (grid %d)\n", hipGetErrorString(e), grid);
#else
    for (int k = 0; k < NPHASE; ++k) { p.ph_lo = k; p.ph_hi = k + 1; hipLaunchKernelGGL(fwd_kernel, dim3(grid), dim3(NTHR), LDS_BYTES, stream, p); }
#endif
}
```

```cpp
#include <hip/hip_runtime.h>
#include <hip/hip_cooperative_groups.h>
#include <cstdio>
#include <cstdint>
namespace cg = cooperative_groups;
namespace pg8 {
#define PG8_LAS __attribute__((address_space(3)))
typedef unsigned short bf16_t;
typedef short bf16x8 __attribute__((ext_vector_type(8)));
typedef float f32x4 __attribute__((ext_vector_type(4)));
typedef unsigned u32x4 __attribute__((ext_vector_type(4)));
constexpr int BM = 256, BK = 64, HALF = 128, HTB = HALF * BK * 2  , STAGE_BYTES = 8 * HTB, NXCD = 8, WGM = 8;

__host__ __device__ __forceinline__ int lds_byte(int r, int c) { const int st = (r >> 4) * 2 + (c >> 5), rr = r & 15, cc = c & 31, ob = rr * 64 + cc * 2; return st * 1024 + (ob ^ (((ob >> 9) & 1) << 5)); }
__host__ __device__ __forceinline__ void stage_rc(int b, int& R, int& C) { const int st = b / 1024, sb = b % 1024, swz = sb ^ (((sb >> 9) & 1) << 5); R = (st >> 1) * 16 + swz / 64; C = (st & 1) * 32 + (swz % 64) / 2; }
__host__ __device__ __forceinline__ int perm32(int rho) { const int n = rho >> 4, i = rho & 15; return 8 * (i >> 2) + 4 * n + (i & 3); }

struct Unit { int pm, pn; };
struct Gemm { const bf16_t* A; const bf16_t* Bt; int M, N, K; };

struct StaticOrder {
    int nM, nN, nwg, G, c;
    __host__ __device__ void init(int M, int N, int G_, int c_) { nM = M / BM; nN = N / BM; nwg = nM * nN; G = G_; c = c_; }
    __host__ __device__ bool next(int i, Unit& u) const {
        const long L = (long)i * G + c; if (L >= nwg) return false;
        int wgid = (int)L; { const int q = nwg / NXCD, r = nwg % NXCD, xcd = wgid % NXCD, off = wgid / NXCD; wgid = (xcd < r ? xcd * (q + 1) : r * (q + 1) + (xcd - r) * q) + off; }
        const int nig = WGM * nN, gid = wgid / nig, fm = gid * WGM, gsz = (nM - fm) < WGM ? (nM - fm) : WGM;
        u.pm = fm + ((wgid % nig) % gsz); u.pn = (wgid % nig) / gsz; return true;
    }
    __device__ __forceinline__ void a_ready(const Unit&) const {}
    __device__ __forceinline__ void done(const Unit&) const {}
};

template <class F> struct Epi8 {
    static constexpr bool PERM = true, AFTER_DRAIN = false;
    F f;
    __device__ __forceinline__ void operator()(const f32x4 (&acc)[2][2][4][2], const Unit& u, int wr, int wc, int fr, int fq) const {
#pragma unroll
        for (int ai = 0; ai < 2; ++ai)
#pragma unroll
            for (int mp = 0; mp < 4; mp += F::MB) {
                typename F::Pre pre[F::MB][2];
#pragma unroll
                for (int m = 0; m < F::MB; ++m)
#pragma unroll
                    for (int bj = 0; bj < 2; ++bj) pre[m][bj] = f.pre(u.pm * BM + ai * HALF + wr * 64 + (mp + m) * 16 + fr, u.pn * BM + bj * HALF + wc * 32 + 8 * fq);
#pragma unroll
                for (int m = 0; m < F::MB; ++m) {
                    const int row = u.pm * BM + ai * HALF + wr * 64 + (mp + m) * 16 + fr;
                    float ss = 0.f;
#pragma unroll
                    for (int bj = 0; bj < 2; ++bj) { const int col = u.pn * BM + bj * HALF + wc * 32 + 8 * fq; ss += f(row, col, acc[ai][bj][mp + m][0], acc[ai][bj][mp + m][1], pre[m][bj]); }
                    if (F::HAS_SS) { ss += __shfl_xor(ss, 16); ss += __shfl_xor(ss, 32); if (fq == 0) f.add_ss(row, ss); }
                }
            }
    }
};
template <class Epi, class Sched, bool ALIGN_EPI = false, bool SP2 = false>
__device__ __forceinline__ void gemm_phase(PG8_LAS unsigned char* lds, const Gemm g, const Sched& S, const Epi& E) {
    const int tid = threadIdx.x, wid = __builtin_amdgcn_readfirstlane(tid >> 6), lane = tid & 63, wr = wid >> 2, wc = wid & 3, fr = lane & 15, fq = lane >> 4;
    const int K = g.K, nt = K / BK;
    unsigned voffA[2], voffB[2];
#pragma unroll
    for (int i = 0; i < 2; ++i) { int R, C; stage_rc(tid * 16 + i * 8192, R, C); const int Rb = Epi::PERM ? ((R & ~31) + perm32(R & 31)) : R;
        voffA[i] = (unsigned)(R * K + C) * 2u; voffB[i] = (unsigned)(Rb * K + C) * 2u; }
    const size_t kstep = (size_t)(BK * 2);
    const size_t hstep = (size_t)HALF * K * 2;
    const size_t tstep = 2 * hstep;
    const unsigned ldsw = (unsigned)wid * 1024u;
    const int aoff = lds_byte(wr * 64 + fr, fq * 8), boff = lds_byte(wc * 32 + fr, fq * 8);
#define PG8_SA(b, h) (((b) * 2 + (h)) * HTB)
#define PG8_SB(b, h) ((4 + (b) * 2 + (h)) * HTB)
#define PG8_STAGE(bufoff, gbase, voff) do { _Pragma("unroll") for (int _i = 0; _i < 2; ++_i) \
        __builtin_amdgcn_global_load_lds((const unsigned*)((const char*)(gbase) + (voff)[_i]), (PG8_LAS unsigned*)(lds + (bufoff) + ldsw + _i * 8192), 16, 0, 0); } while (0)
#define PG8_LDA(dst, b, h) do { _Pragma("unroll") for (int m = 0; m < 4; ++m) _Pragma("unroll") for (int k = 0; k < 2; ++k) dst[m][k] = *(const PG8_LAS bf16x8*)(lds + PG8_SA(b, h) + aoff + m * 2048 + k * 1024); } while (0)
#define PG8_LDB(dst, b, h) do { _Pragma("unroll") for (int n = 0; n < 2; ++n) _Pragma("unroll") for (int k = 0; k < 2; ++k) dst[n][k] = *(const PG8_LAS bf16x8*)(lds + PG8_SB(b, h) + boff + n * 2048 + k * 1024); } while (0)
#define PG8_MMA(ai, bj, At, Bt) do { __builtin_amdgcn_s_setprio(1); _Pragma("unroll") for (int m = 0; m < 4; ++m) _Pragma("unroll") for (int n = 0; n < 2; ++n) _Pragma("unroll") for (int k = 0; k < 2; ++k) \
        acc[ai][bj][m][n] = __builtin_amdgcn_mfma_f32_16x16x32_bf16(Bt[n][k], At[m][k], acc[ai][bj][m][n], 0, 0, 0); __builtin_amdgcn_s_setprio(0); } while (0)
#define PG8_WAIT_V(n) asm volatile("s_waitcnt vmcnt(" #n ")" ::: "memory")
#define PG8_WAIT_L(n) asm volatile("s_waitcnt lgkmcnt(" #n ")" ::: "memory")
#define PG8_BAR __builtin_amdgcn_s_barrier()
#define PG8_SCHED __builtin_amdgcn_sched_barrier(0)
    Unit cur, nxt; int ui = 0;
    if (!S.next(0, cur)) return;
    f32x4 acc[2][2][4][2];
#pragma unroll
    for (int a = 0; a < 2; ++a)
#pragma unroll
        for (int b = 0; b < 2; ++b)
#pragma unroll
            for (int m = 0; m < 4; ++m)
#pragma unroll
                for (int n = 0; n < 2; ++n) acc[a][b][m][n] = (f32x4){0.f, 0.f, 0.f, 0.f};
    bf16x8 At[4][2], B0[2][2], B1[2][2];
    const char* cA = (const char*)g.A + (size_t)cur.pm * tstep; const char* cB = (const char*)g.Bt + (size_t)cur.pn * tstep;
    S.a_ready(cur);
    if constexpr (SP2) {
        PG8_STAGE(PG8_SB(0, 0), cB, voffB); PG8_STAGE(PG8_SB(0, 1), cB + hstep, voffB); PG8_STAGE(PG8_SA(0, 0), cA, voffA); PG8_STAGE(PG8_SA(0, 1), cA + hstep, voffA);
        if (wr == 1) PG8_BAR;
        PG8_WAIT_V(2); PG8_BAR;
        PG8_STAGE(PG8_SB(1, 0), cB + kstep, voffB); PG8_STAGE(PG8_SA(1, 0), cA + kstep, voffA); PG8_STAGE(PG8_SB(1, 1), cB + hstep + kstep, voffB);
        PG8_WAIT_V(6); PG8_BAR;
    } else {
        PG8_STAGE(PG8_SB(0, 0), cB, voffB); PG8_STAGE(PG8_SA(0, 0), cA, voffA); PG8_STAGE(PG8_SB(0, 1), cB + hstep, voffB); PG8_STAGE(PG8_SA(0, 1), cA + hstep, voffA);
        if (wr == 1) PG8_BAR;
        PG8_WAIT_V(4); PG8_BAR;
        PG8_STAGE(PG8_SB(1, 0), cB + kstep, voffB); PG8_STAGE(PG8_SA(1, 0), cA + kstep, voffA); PG8_STAGE(PG8_SB(1, 1), cB + hstep + kstep, voffB);
        PG8_WAIT_V(6); PG8_BAR;
    }
    for (;;) {
        const bool has_next = S.next(ui + 1, nxt);
        const char* nA = has_next ? (const char*)g.A + (size_t)nxt.pm * tstep : cA; const char* nB = has_next ? (const char*)g.Bt + (size_t)nxt.pn * tstep : cB;
        for (int t = 0; t < nt; t += 2) {
            const bool last = (t == nt - 2);
            const char* a1 = cA + (size_t)(t + 1) * kstep;
            const char* a2 = last ? nA : cA + (size_t)(t + 2) * kstep; const char* b2 = last ? nB : cB + (size_t)(t + 2) * kstep;
            const char* a3 = a2 + kstep; const char* b3 = b2 + kstep;
            if (last && has_next) S.a_ready(nxt);
            if constexpr (SP2) {
            PG8_LDB(B0, 0, 0); PG8_LDB(B1, 0, 1); PG8_SCHED; PG8_LDA(At, 0, 0); PG8_STAGE(PG8_SA(1, 1), a1 + hstep, voffA);
            PG8_WAIT_V(8); PG8_WAIT_L(0); PG8_BAR; PG8_MMA(0, 0, At, B0); PG8_MMA(0, 1, At, B1); PG8_BAR; PG8_SCHED;
            PG8_LDA(At, 0, 1); PG8_STAGE(PG8_SB(0, 0), b2, voffB); PG8_STAGE(PG8_SB(0, 1), b2 + hstep, voffB); PG8_STAGE(PG8_SA(0, 0), a2, voffA);
            PG8_WAIT_V(8); PG8_WAIT_L(0); PG8_BAR; PG8_MMA(1, 0, At, B0); PG8_MMA(1, 1, At, B1); PG8_BAR; PG8_SCHED;
            PG8_LDB(B0, 1, 0); PG8_LDB(B1, 1, 1); PG8_SCHED; PG8_LDA(At, 1, 0); PG8_STAGE(PG8_SA(0, 1), a2 + hstep, voffA);
            PG8_WAIT_V(8); PG8_WAIT_L(0); PG8_BAR; PG8_MMA(0, 0, At, B0); PG8_MMA(0, 1, At, B1); PG8_BAR; PG8_SCHED;
            PG8_LDA(At, 1, 1); PG8_STAGE(PG8_SB(1, 0), b3, voffB); PG8_STAGE(PG8_SB(1, 1), b3 + hstep, voffB); PG8_STAGE(PG8_SA(1, 0), a3, voffA);
            PG8_WAIT_V(8); PG8_WAIT_L(0); PG8_BAR; PG8_MMA(1, 0, At, B0); PG8_MMA(1, 1, At, B1); PG8_BAR; PG8_SCHED;
            } else {
            PG8_LDB(B0, 0, 0); PG8_SCHED; PG8_LDA(At, 0, 0); PG8_STAGE(PG8_SA(1, 1), a1 + hstep, voffA);
            PG8_WAIT_L(8); PG8_BAR; PG8_WAIT_L(0); PG8_MMA(0, 0, At, B0); PG8_BAR; PG8_SCHED;
            PG8_LDB(B1, 0, 1); PG8_STAGE(PG8_SB(0, 0), b2, voffB);
            PG8_BAR; PG8_WAIT_L(0); PG8_MMA(0, 1, At, B1); PG8_BAR;
            PG8_LDA(At, 0, 1); PG8_STAGE(PG8_SA(0, 0), a2, voffA);
            PG8_BAR; PG8_WAIT_L(0); PG8_MMA(1, 0, At, B0); PG8_BAR; PG8_SCHED;
            PG8_STAGE(PG8_SB(0, 1), b2 + hstep, voffB);
            PG8_WAIT_V(6); PG8_BAR; PG8_MMA(1, 1, At, B1); PG8_BAR;
            PG8_LDB(B0, 1, 0); PG8_SCHED; PG8_LDA(At, 1, 0); PG8_STAGE(PG8_SA(0, 1), a2 + hstep, voffA);
            PG8_WAIT_L(8); PG8_BAR; PG8_WAIT_L(0); PG8_MMA(0, 0, At, B0); PG8_BAR; PG8_SCHED;
            PG8_LDB(B1, 1, 1); PG8_STAGE(PG8_SB(1, 0), b3, voffB);
            PG8_BAR; PG8_WAIT_L(0); PG8_MMA(0, 1, At, B1); PG8_BAR;
            PG8_LDA(At, 1, 1); PG8_STAGE(PG8_SA(1, 0), a3, voffA);
            PG8_BAR; PG8_WAIT_L(0); PG8_MMA(1, 0, At, B0); PG8_BAR; PG8_SCHED;
            PG8_STAGE(PG8_SB(1, 1), b3 + hstep, voffB);
            PG8_WAIT_V(6); PG8_BAR; PG8_MMA(1, 1, At, B1); PG8_BAR;
            }
        }
        if constexpr (ALIGN_EPI) { if (wr == 0) PG8_BAR; }
        if constexpr (!Epi::AFTER_DRAIN) { E(acc, cur, wr, wc, fr, fq); S.done(cur); }
        if (!has_next) break;
#pragma unroll
        for (int a = 0; a < 2; ++a)
#pragma unroll
            for (int b = 0; b < 2; ++b)
#pragma unroll
                for (int m = 0; m < 4; ++m)
#pragma unroll
                    for (int n = 0; n < 2; ++n) acc[a][b][m][n] = (f32x4){0.f, 0.f, 0.f, 0.f};
        cur = nxt; cA = nA; cB = nB; ++ui;
        if constexpr (ALIGN_EPI) { if (wr == 1) PG8_BAR; }
    }
    PG8_WAIT_V(0);
    if constexpr (!ALIGN_EPI) { if (wr == 0) PG8_BAR; }
    PG8_BAR;
    if constexpr (Epi::AFTER_DRAIN) { E.fused(acc, cur, wr, wc, fr, fq, lds, wid, lane); S.done(cur); }
#undef PG8_SA
#undef PG8_SB
#undef PG8_STAGE
#undef PG8_LDA
#undef PG8_LDB
#undef PG8_MMA
#undef PG8_WAIT_V
#undef PG8_WAIT_L
#undef PG8_BAR
#undef PG8_SCHED
}
}

#define LAS __attribute__((address_space(3)))
typedef unsigned short bf16_t;
typedef short bf16x8 __attribute__((ext_vector_type(8)));
typedef float f32x4 __attribute__((ext_vector_type(4)));
typedef unsigned u32x4 __attribute__((ext_vector_type(4)));
typedef unsigned u32x2 __attribute__((ext_vector_type(2)));

constexpr int D = 1024, NB = 8, SEQ = 2048, NDEC = 128;
constexpr int RMAIN = 16384, RMETA0 = 16384, RDEC0 = 16512, R = 16640, RP = 16512;
constexpr int DIN = 7192, CA = 1536, DFF = 2816, NCH = 33;
constexpr int NA = 3840, LDA_ = 3584, NBW = 3584;
constexpr int NITEM = NB * 4 * NCH;
constexpr float EPS = 1e-6f;
constexpr int NTHR = 512, LDS_BYTES = 147456;

constexpr size_t O_YP = 0, O_YS = 16777216, O_DP = 16908288, O_DCP = 17432576, O_GP = 17469440, O_FCP = 18518016,
                 O_DS = 18563072, O_DCS = 26951680, O_GS = 27541504, O_FCS = 44318720, O_END = 45039616;
constexpr size_t DS_HN = 0, DS_OA = DS_HN + (size_t)R * 1024 * 2, DS_SMALL = DS_OA + (size_t)R * 512 * 2, DS_ATTB = DS_SMALL + (size_t)R * 32 * 4,
                 DS_EGL = DS_ATTB + (size_t)NITEM * 8192, DS_EBL = DS_EGL + 8192, DS_SSO = DS_EBL + (size_t)NITEM * 128 * 4  , DS_END = DS_SSO + (size_t)R * 64 * 4;
static_assert(DS_END <= 16777216ull * 4, "d_out scratch");
constexpr size_t MiB = 1u << 20;
constexpr size_t WS_WTA = 0, WS_WTB = WS_WTA + (size_t)NA * 1024 * 2, WS_WA = WS_WTB + (size_t)NBW * 1024 * 2, WS_WB = WS_WA + 1024 * 512 * 2,
                 WS_WO = WS_WB + 1024 * 1024 * 2, WS_WF1 = WS_WO + 1024 * 1024 * 2, WS_WF2 = WS_WF1 + (size_t)5632 * 1024 * 2,
                 WS_CTL = WS_WF2 + (size_t)1024 * 2816 * 2, WS_BIG = WS_CTL + MiB / 4;
constexpr size_t WS_SS2 = WS_CTL, WS_SS3 = WS_CTL + 128 * 1024, WS_BAR = WS_CTL + 200 * 1024, WS_ZERO = WS_CTL + 216 * 1024  , WS_ONES = WS_CTL + 224 * 1024  , WS_JUNK = WS_CTL + 228 * 1024  ;
constexpr size_t WS_PROJA = WS_BIG, WS_QT = WS_PROJA + (size_t)R * LDA_ * 2, WS_KT = WS_QT + (size_t)RP * 512 * 2, WS_WW = WS_KT + (size_t)RP * 512 * 2,
                 WS_UU = WS_WW + (size_t)RP * 512 * 2, WS_ATTA = WS_UU + (size_t)RP * 512 * 2, WS_OB = WS_ATTA + (size_t)NITEM * 8192, WS_END1 = WS_OB + (size_t)R * 1024 * 2;
static_assert(WS_END1 <= 256 * MiB, "ws map 1");
constexpr size_t WS_Z = WS_BIG, WS_SG = WS_Z + (size_t)R * 1536 * 2;
static_assert(WS_SG + (size_t)R * 2048 * 2 <= WS_QT, "ws map 2");
constexpr size_t WS_MIX = WS_QT;
constexpr size_t WS_HN2 = WS_OB;
constexpr size_t WS_U = WS_BIG, WS_GF = WS_U + (size_t)R * DFF * 2;
constexpr size_t WS_HALO = WS_U, WS_FIXU = WS_HALO + (size_t)512 * DFF * 2, WS_FIXG = WS_FIXU + (size_t)512 * DFF * 2, WS_RAWU = WS_FIXG + (size_t)512 * DFF * 2, WS_RAWG = WS_RAWU + (size_t)256 * DFF * 2;
static_assert(WS_RAWG + (size_t)256 * DFF * 2 <= WS_GF, "side buffers");
static_assert(WS_GF + (size_t)R * DFF * 2 <= WS_HN2, "ws map 3");
static_assert(WS_MIX + (size_t)R * 1024 * 2 <= WS_OB, "ws map 4");

struct Params { const float* in[25]; float* out; unsigned char* ws; int ph_lo, ph_hi; };
enum { I_XP = 0, I_XS, I_SD, I_SDC, I_SG, I_SFC, I_META, I_NMIX, I_WIN, I_WCA, I_ALOG, I_DTB, I_WGK2, I_BGK, I_ONA, I_ONB, I_WAO, I_WBO, I_WO, I_NFFN, I_WFI, I_WCF, I_BCF, I_WFO, I_NFIN };

typedef float f32x2_t __attribute__((ext_vector_type(2)));
typedef __bf16 bf16x2_t __attribute__((ext_vector_type(2)));
__device__ __forceinline__ unsigned pk2(float lo, float hi) { f32x2_t v = {lo, hi}; bf16x2_t b = __builtin_convertvector(v, bf16x2_t); return __builtin_bit_cast(unsigned, b); }
__device__ __forceinline__ unsigned f2bf(float f) { return pk2(f, 0.f) & 0xffffu; }
__device__ __forceinline__ float bflo(unsigned w) { return __builtin_bit_cast(float, w << 16); }
__device__ __forceinline__ float bfhi(unsigned w) { return __builtin_bit_cast(float, w & 0xffff0000u); }
__device__ __forceinline__ float bf2f(bf16_t h) { return __builtin_bit_cast(float, ((unsigned)h) << 16); }
__device__ __forceinline__ void unpack8(u32x4 w, float* f) { f[0] = bflo(w.x); f[1] = bfhi(w.x); f[2] = bflo(w.y); f[3] = bfhi(w.y); f[4] = bflo(w.z); f[5] = bfhi(w.z); f[6] = bflo(w.w); f[7] = bfhi(w.w); }
__device__ __forceinline__ u32x4 pack8(const float* f) { u32x4 w; w.x = pk2(f[0], f[1]); w.y = pk2(f[2], f[3]); w.z = pk2(f[4], f[5]); w.w = pk2(f[6], f[7]); return w; }
__device__ __forceinline__ float wave_sum(float v) {
#pragma unroll
    for (int o = 1; o < 64; o <<= 1) v += __shfl_xor(v, o);
    return v;
}
__device__ __forceinline__ float sigmoidf_(float x) { return __builtin_amdgcn_rcpf(1.f + __expf(-x)); }
__device__ __forceinline__ float siluf_(float x) { return x * __builtin_amdgcn_rcpf(1.f + __expf(-x)); }
__device__ __forceinline__ float softplusf_(float x) { return fmaxf(x, 0.f) + __logf(1.f + __expf(-fabsf(x))); }
__device__ __forceinline__ float gelu_tanh(float x) { const float t = x * (-2.302208198f + -0.1029432397f * x * x); return x * __builtin_amdgcn_rcpf(1.f + __builtin_amdgcn_exp2f(t)); }
#define LDS_WAIT() asm volatile("s_waitcnt lgkmcnt(0)" ::: "memory")
template <int CTRL, int ROWMASK> __device__ __forceinline__ float dpp_add(float v) { return v + __builtin_bit_cast(float, __builtin_amdgcn_update_dpp(0, __builtin_bit_cast(int, v), CTRL, ROWMASK, 0xf, true)); }
__device__ __forceinline__ float wave_incl_scan(float v) {
    v = dpp_add<0x111, 0xf>(v); v = dpp_add<0x112, 0xf>(v); v = dpp_add<0x114, 0xf>(v); v = dpp_add<0x118, 0xf>(v);
    v = dpp_add<0x142, 0xa>(v);
    v = dpp_add<0x143, 0xc>(v);
    return v;
}
__device__ __forceinline__ void lds_barrier() { asm volatile("s_waitcnt lgkmcnt(0)\n\ts_barrier" ::: "memory"); }
#define MFMA16(a, b, c) __builtin_amdgcn_mfma_f32_16x16x32_bf16(a, b, c, 0, 0, 0)
typedef short s16x4 __attribute__((ext_vector_type(4)));
__device__ __forceinline__ s16x4 ldtr(const LAS bf16_t* p) { return __builtin_bit_cast(s16x4, __builtin_amdgcn_ds_read_tr16_b64_v4i16((LAS s16x4*)p)); }
__device__ __forceinline__ bf16x8 trfrag(const LAS bf16_t* base, int stride, int k0, int col0, int fr, int fq) {
    const LAS bf16_t* p0 = base + (k0 + 8 * fq + (fr >> 2)) * stride + col0 + 4 * (fr & 3);
    const s16x4 lo = ldtr(p0), hi = ldtr(p0 + 4 * stride);
    return (bf16x8){lo[0], lo[1], lo[2], lo[3], hi[0], hi[1], hi[2], hi[3]};
}
__device__ __forceinline__ bf16x8 lfrag(const LAS bf16_t* base, int row, int stride, int k0, int q) { return *(const LAS bf16x8*)(base + row * stride + k0 + 8 * q); }

__device__ __forceinline__ const float* xrow_ptr(const Params& p, int row) {
    if (row < RMAIN) return p.in[I_XP] + (size_t)row * D;
    if (row < RDEC0) return p.in[I_META] + (size_t)((row - RMETA0) & 15) * D;
    return p.in[I_XS] + (size_t)(row - RDEC0) * D;
}
__device__ __forceinline__ int prow(int b, int c, int ii) {
    if (c == 0) return ii >= 48 ? RMETA0 + b * 16 + (ii - 48) : -1;
    if (ii >= 0 || c >= 2) return b * SEQ + 64 * (c - 1) + ii;
    return RMETA0 + b * 16 + 16 + ii;
}
__device__ __forceinline__ long yslot(int row) { if (row < RMAIN) return (long)O_YP + (long)row * D; if (row >= RDEC0) return (long)O_YS + (long)(row - RDEC0) * D; return -1; }

__device__ __forceinline__ void transpose_item(const float* W, int ldW, int col0, int K, bf16_t* WT, int row_off, int nblk, LAS float* scr, int item, int lane, int perm) {
    const int kb = item / nblk, nb = item % nblk, k0 = 64 * kb, n0 = 32 * nb;
#pragma unroll 8
    for (int i = 0; i < 32; ++i) { const int kk = 2 * i + (lane >> 5); scr[kk * 33 + (lane & 31)] = W[(size_t)(k0 + kk) * ldW + col0 + n0 + (lane & 31)]; }
    LDS_WAIT();
    const int c = lane & 7;
#pragma unroll
    for (int j = 0; j < 4; ++j) { const int n = (lane >> 3) + 8 * j; const LAS float* s = scr + (8 * c) * 33 + n;
        u32x4 o; o.x = pk2(s[0 * 33], s[1 * 33]); o.y = pk2(s[2 * 33], s[3 * 33]); o.z = pk2(s[4 * 33], s[5 * 33]); o.w = pk2(s[6 * 33], s[7 * 33]);
        const int drow = perm ? (n0 < DFF ? 256 * (n0 >> 7) + (n0 & 127) : 256 * ((n0 - DFF) >> 7) + 128 + ((n0 - DFF) & 127)) + n : row_off + n0 + n;
        *(u32x4*)(WT + (size_t)drow * K + k0 + 8 * c) = o; }
    LDS_WAIT();
}
struct Seg { const float* W; int ldW, col0, K, ncols; bf16_t* WT; int row_off; int perm; };

template <int SG_LO, int SG_HI> __device__ __forceinline__ void transpose_segs(const Params& p, LAS unsigned char* lds, int widx, int nw) {
    const int lane = threadIdx.x & 63, wave = threadIdx.x >> 6;
    unsigned char* ws = p.ws; LAS float* scr = (LAS float*)(lds + wave * 16384);
    bf16_t* WTA = (bf16_t*)(ws + WS_WTA); bf16_t* WTB = (bf16_t*)(ws + WS_WTB); const float* win = p.in[I_WIN];
#pragma unroll
    for (int sg = SG_LO; sg < SG_HI; ++sg) {
        Seg s;
        switch (sg) {
            case 0: s = Seg{win, DIN, 0, 1024, 1536, WTA, 0, 0}; break;
            case 1: s = Seg{win, DIN, 2056, 1024, 1024, WTA, 1536, 0}; break;
            case 2: s = Seg{win, DIN, 3080, 1024, 1024, WTA, 2560, 0}; break;
            case 3: s = Seg{win, DIN, 1536, 1024, 512, WTB, 0, 0}; break;
            case 4: s = Seg{win, DIN, 4104, 1024, 1024, WTB, 512, 0}; break;
            case 5: s = Seg{win, DIN, 5144, 1024, 2048, WTB, 1536, 0}; break;
            case 6: s = Seg{p.in[I_WAO], 1024, 0, 512, 1024, (bf16_t*)(ws + WS_WA), 0, 0}; break;
            case 7: s = Seg{p.in[I_WBO], 1024, 0, 1024, 1024, (bf16_t*)(ws + WS_WB), 0, 0}; break;
            case 8: s = Seg{p.in[I_WO], 1024, 0, 1024, 1024, (bf16_t*)(ws + WS_WO), 0, 0}; break;
            case 9: s = Seg{p.in[I_WFI], 5632, 0, 1024, 5632, (bf16_t*)(ws + WS_WF1), 0, 1}; break;
            default: s = Seg{p.in[I_WFO], 1024, 0, 2816, 1024, (bf16_t*)(ws + WS_WF2), 0, 0}; break;
        }
        const int nblk = s.ncols / 32, nit = (s.K / 64) * nblk;
        for (int it = widx; it < nit; it += nw) transpose_item(s.W, s.ldW, s.col0, s.K, s.WT, s.row_off, nblk, scr, it, lane, s.perm);
    }
}
template <int SG_LO, int SG_HI> __device__ __forceinline__ void transposes_in_idle_slots(const Params& p, LAS unsigned char* lds, int nwg) {
    const int G = gridDim.x, wave = threadIdx.x >> 6, rounds = (nwg + G - 1) / G, first_short = nwg - (rounds - 1) * G;
    if (first_short < G) { if ((int)blockIdx.x >= first_short) transpose_segs<SG_LO, SG_HI>(p, lds, ((int)blockIdx.x - first_short) * 8 + wave, (G - first_short) * 8); }
    else transpose_segs<SG_LO, SG_HI>(p, lds, (int)blockIdx.x * 8 + wave, G * 8);
}

__device__ __forceinline__ void p0_prologue(const Params& p, LAS unsigned char* lds) {
    const int tid = threadIdx.x, lane = tid & 63, wave = tid >> 6;
    const int gw = blockIdx.x * 8 + wave, NGW = gridDim.x * 8;
    unsigned char* ws = p.ws;
    LAS float* scr = (LAS float*)(lds + wave * 16384);
    bf16_t* WTA = (bf16_t*)(ws + WS_WTA); bf16_t* WTB = (bf16_t*)(ws + WS_WTB);
    const float* win = p.in[I_WIN];
    transpose_segs<0, 6>(p, lds, gw, NGW);
    const int gt = blockIdx.x * NTHR + tid, NGT = gridDim.x * NTHR;
    for (int e = gt; e < 256 * 1024; e += NGT) {
        const int c = e >> 10, k = e & 1023; float v = 0.f;
        if (c < 8) v = win[(size_t)k * DIN + 2048 + c]; else if (c < 24) v = win[(size_t)k * DIN + 5128 + (c - 8)];
        WTA[(size_t)(3584 + c) * 1024 + k] = (bf16_t)f2bf(v);
    }
    for (int e = gt; e < 224 * 256; e += NGT) ((float*)(ws + WS_CTL))[e] = 0.f;
    if (gt < 256) ((float*)(ws + WS_ONES))[gt] = 1.f;
    bf16_t* HN = (bf16_t*)((unsigned char*)p.out + DS_HN);
    const float* nw = p.in[I_NMIX];
    for (int row = gw; row < R; row += NGW) {
        const f32x4* xr = (const f32x4*)xrow_ptr(p, row) + lane;
        f32x4 v[4]; float s = 0.f;
#pragma unroll
        for (int j = 0; j < 4; ++j) { v[j] = xr[64 * j]; s += (v[j].x * v[j].x + v[j].y * v[j].y) + (v[j].z * v[j].z + v[j].w * v[j].w); }
        const float rstd = rsqrtf(wave_sum(s) * (1.f / D) + EPS);
        u32x2* o = (u32x2*)(HN + (size_t)row * D) + lane;
#pragma unroll
        for (int j = 0; j < 4; ++j) { const f32x4 w = ((const f32x4*)nw)[lane + 64 * j]; u32x2 q; q.x = pk2(v[j].x * rstd * w.x, v[j].y * rstd * w.y); q.y = pk2(v[j].z * rstd * w.z, v[j].w * rstd * w.w); o[64 * j] = q; }
    }
}

struct FA {
    static constexpr bool HAS_SS = false; static constexpr int MB = 4;
    bf16_t* PA; float* SM;
    struct Pre {}; __device__ __forceinline__ Pre pre(int, int) const { return Pre{}; }
    __device__ __forceinline__ float operator()(int row, int col, f32x4 a, f32x4 b, Pre) const {
        if (col < LDA_) { u32x4 w; w.x = pk2(a.x, a.y); w.y = pk2(a.z, a.w); w.z = pk2(b.x, b.y); w.w = pk2(b.z, b.w); *(u32x4*)(PA + (size_t)row * LDA_ + col) = w; }
        else { const int c = col - LDA_; if (c < 24) { float* o = SM + (size_t)row * 32 + c; *(f32x4*)o = a; *(f32x4*)(o + 4) = b; } }
        return 0.f;
    }
    __device__ __forceinline__ void add_ss(int, float) const {}
};
struct FB {
    static constexpr bool HAS_SS = false; static constexpr int MB = 2;
    bf16_t* OA; bf16_t* OB; const float* SSO; const float* ona; const float* onb; bf16_t* SGp;
    struct Pre { u32x4 o; f32x4 s0, s1; };
    __device__ __forceinline__ Pre pre(int row, int col) const {
        Pre r;
        if (col < 1536) {
            const int hidx = col < 512 ? (col >> 7) : 4 + ((col - 512) >> 8);
            const bf16_t* op = col < 512 ? OA + (size_t)row * 512 + col : OB + (size_t)row * 1024 + (col - 512);
            r.o = *(const u32x4*)op; const f32x4* sp = (const f32x4*)(SSO + ((size_t)row * 8 + hidx) * 8); r.s0 = sp[0]; r.s1 = sp[1];
        } else { r.o = (u32x4){0u, 0u, 0u, 0u}; r.s0 = (f32x4){0.f, 0.f, 0.f, 0.f}; r.s1 = r.s0; }
        return r;
    }
    __device__ __forceinline__ float operator()(int row, int col, f32x4 a, f32x4 b, Pre pr) const {
        if (col < 1536) {
            const bool isA = col < 512; const int c2 = col - 512;
            const float ss = ((pr.s0.x + pr.s0.y) + (pr.s0.z + pr.s0.w)) + ((pr.s1.x + pr.s1.y) + (pr.s1.z + pr.s1.w));
            const float rs = rsqrtf(ss * (isA ? 1.f / 128.f : 1.f / 256.f) + EPS);
            const float* nw = isA ? ona + (col & 127) : onb + (c2 & 255);
            const f32x4 n0 = *(const f32x4*)nw, n1 = *(const f32x4*)(nw + 4);
            float o[8]; unpack8(pr.o, o);
            const float z[8] = {a.x, a.y, a.z, a.w, b.x, b.y, b.z, b.w}; const float nn[8] = {n0.x, n0.y, n0.z, n0.w, n1.x, n1.y, n1.z, n1.w};
#pragma unroll
            for (int e = 0; e < 8; ++e) o[e] = o[e] * rs * nn[e] * siluf_(z[e]);
            bf16_t* op = isA ? OA + (size_t)row * 512 + col : OB + (size_t)row * 1024 + c2;
            *(u32x4*)op = pack8(o);
        } else { u32x4 w; w.x = pk2(sigmoidf_(a.x), sigmoidf_(a.y)); w.y = pk2(sigmoidf_(a.z), sigmoidf_(a.w)); w.z = pk2(sigmoidf_(b.x), sigmoidf_(b.y)); w.w = pk2(sigmoidf_(b.z), sigmoidf_(b.w));
               *(u32x4*)(SGp + (size_t)row * 2048 + (col - 1536)) = w; }
        return 0.f;
    }
    __device__ __forceinline__ void add_ss(int, float) const {}
};
template <int SECOND> struct FMix {
    static constexpr bool HAS_SS = false; static constexpr int MB = 4;
    const bf16_t* SGp; bf16_t* MIX;
    struct Pre { u32x4 g, m; };
    __device__ __forceinline__ Pre pre(int row, int col) const { Pre r; r.g = *(const u32x4*)(SGp + (size_t)row * 2048 + SECOND * 1024 + col);
        if (SECOND) r.m = *(const u32x4*)(MIX + (size_t)row * 1024 + col); else r.m = (u32x4){0u, 0u, 0u, 0u}; return r; }
    __device__ __forceinline__ float operator()(int row, int col, f32x4 a, f32x4 b, Pre pr) const {
        float g[8], v[8] = {a.x, a.y, a.z, a.w, b.x, b.y, b.z, b.w};
        unpack8(pr.g, g);
        u32x4* mp = (u32x4*)(MIX + (size_t)row * 1024 + col);
        if (SECOND) { float m[8]; unpack8(pr.m, m);
#pragma unroll
            for (int i = 0; i < 8; ++i) v[i] = m[i] + g[i] * v[i]; }
        else {
#pragma unroll
            for (int i = 0; i < 8; ++i) v[i] = g[i] * v[i]; }
        *mp = pack8(v);
        return 0.f;
    }
    __device__ __forceinline__ void add_ss(int, float) const {}
};
struct FX2 {
    static constexpr bool HAS_SS = true; static constexpr int MB = 4;
    const float* xp_; const float* meta_; const float* xs_; float* out_; const float* nffn_; bf16_t* HN2; float* SS2;
    struct Pre { f32x4 x0, x1; };
    __device__ __forceinline__ Pre pre(int row, int col) const {
        const float* xr = (row < RMAIN ? xp_ + (size_t)row * D : (row < RDEC0 ? meta_ + (size_t)((row - RMETA0) & 15) * D : xs_ + (size_t)(row - RDEC0) * D)) + col;
        Pre r; r.x0 = *(const f32x4*)xr; r.x1 = *(const f32x4*)(xr + 4); return r; }
    __device__ __forceinline__ float operator()(int row, int col, f32x4 a, f32x4 b, Pre pr) const {
        a = a + pr.x0; b = b + pr.x1;
        const long ys = yslot(row);
        if (ys >= 0) { float* o = out_ + ys + col; *(f32x4*)o = a; *(f32x4*)(o + 4) = b; }
        const float* nw = nffn_ + col; const f32x4 w0 = *(const f32x4*)nw, w1 = *(const f32x4*)(nw + 4);
        u32x4 w; w.x = pk2(a.x * w0.x, a.y * w0.y); w.y = pk2(a.z * w0.z, a.w * w0.w); w.z = pk2(b.x * w1.x, b.y * w1.y); w.w = pk2(b.z * w1.z, b.w * w1.w);
        *(u32x4*)(HN2 + (size_t)row * 1024 + col) = w;
        return (a.x * a.x + a.y * a.y) + (a.z * a.z + a.w * a.w) + (b.x * b.x + b.y * b.y) + (b.z * b.z + b.w * b.w);
    }
    __device__ __forceinline__ void add_ss(int row, float s) const { atomicAdd(SS2 + row, s); }
};
struct FF1 {
    static constexpr bool HAS_SS = false; static constexpr int MB = 4;
    const float* SS2; bf16_t* U; bf16_t* GF;
    struct Pre { float ss; }; __device__ __forceinline__ Pre pre(int row, int) const { return Pre{SS2[row]}; }
    __device__ __forceinline__ float operator()(int row, int col, f32x4 a, f32x4 b, Pre pr) const {
        const float rs = rsqrtf(pr.ss * (1.f / D) + EPS);
        u32x4 w; w.x = pk2(a.x * rs, a.y * rs); w.y = pk2(a.z * rs, a.w * rs); w.z = pk2(b.x * rs, b.y * rs); w.w = pk2(b.z * rs, b.w * rs);
        bf16_t* o = col < DFF ? U + (size_t)row * DFF + col : GF + (size_t)row * DFF + (col - DFF);
        *(u32x4*)o = w;
        return 0.f;
    }
    __device__ __forceinline__ void add_ss(int, float) const {}
};
struct FF2 {
    static constexpr bool HAS_SS = true; static constexpr int MB = 4;
    float* out; float* SS3;
    struct Pre { f32x4 x0, x1; };
    __device__ __forceinline__ Pre pre(int row, int col) const { Pre r; const long ys = yslot(row);
        if (ys >= 0) { const float* o = out + ys + col; r.x0 = *(const f32x4*)o; r.x1 = *(const f32x4*)(o + 4); } else { r.x0 = (f32x4){0.f, 0.f, 0.f, 0.f}; r.x1 = r.x0; } return r; }
    __device__ __forceinline__ float operator()(int row, int col, f32x4 a, f32x4 b, Pre pr) const {
        const long ys = yslot(row); if (ys < 0) return 0.f;
        float* o = out + ys + col;
        a = a + pr.x0; b = b + pr.x1;
        *(f32x4*)o = a; *(f32x4*)(o + 4) = b;
        return (a.x * a.x + a.y * a.y) + (a.z * a.z + a.w * a.w) + (b.x * b.x + b.y * b.y) + (b.z * b.z + b.w * b.w);
    }
    __device__ __forceinline__ void add_ss(int row, float s) const { atomicAdd(SS3 + row, s); }
};

template <int CTRL> __device__ __forceinline__ float dpp_f(float v) { return __builtin_bit_cast(float, __builtin_amdgcn_update_dpp(0, __builtin_bit_cast(int, v), CTRL, 0xf, 0xf, false)); }
struct EpiAct {
    static constexpr bool PERM = true, AFTER_DRAIN = false;
    unsigned char* wsb; const float* wcf; const float* bcf;
    __device__ __forceinline__ void operator()(const f32x4 (&acc)[2][2][4][2], const pg8::Unit& u, int wr, int wc, int fr, int fq) const {
        { int lane_ = (int)__builtin_amdgcn_mbcnt_hi(~0u, __builtin_amdgcn_mbcnt_lo(~0u, 0u)); asm volatile("" : "+v"(lane_)); fr = lane_ & 15; fq = lane_ >> 4; }
        const float* SS2 = (const float*)(wsb + WS_SS2); bf16_t* ACT = (bf16_t*)(wsb + WS_GF); bf16_t* HALO = (bf16_t*)(wsb + WS_HALO); bf16_t* FIXU = (bf16_t*)(wsb + WS_FIXU);
        bf16_t* FIXG = (bf16_t*)(wsb + WS_FIXG); bf16_t* RAWU = (bf16_t*)(wsb + WS_RAWU); bf16_t* RAWG = (bf16_t*)(wsb + WS_RAWG);
        const int cu0 = u.pn * 128 + wc * 32 + 8 * fq;
        if (u.pm == RMAIN / 256) {
#pragma unroll
            for (int ai = 0; ai < 2; ++ai)
#pragma unroll
                for (int m = 0; m < 4; ++m) {
                    const int lr = ai * 128 + wr * 64 + m * 16 + fr; const float rs = rsqrtf(SS2[RMAIN + lr] * (1.f / D) + EPS);
                    const f32x4 a0 = acc[ai][0][m][0] * rs, a1 = acc[ai][0][m][1] * rs, g0 = acc[ai][1][m][0] * rs, g1 = acc[ai][1][m][1] * rs;
                    u32x4 w; w.x = pk2(a0.x, a0.y); w.y = pk2(a0.z, a0.w); w.z = pk2(a1.x, a1.y); w.w = pk2(a1.z, a1.w); *(u32x4*)(RAWU + (size_t)lr * DFF + cu0) = w;
                    w.x = pk2(g0.x, g0.y); w.y = pk2(g0.z, g0.w); w.z = pk2(g1.x, g1.y); w.w = pk2(g1.z, g1.w); *(u32x4*)(RAWG + (size_t)lr * DFF + cu0) = w;
                }
            return;
        }
#pragma unroll
        for (int ai = 0; ai < 2; ++ai) {
            const int rowb = u.pm * 256 + ai * 128 + wr * 64, blk = rowb >> 6;
            float rs[4];
#pragma unroll
            for (int m = 0; m < 4; ++m) rs[m] = rsqrtf(SS2[rowb + m * 16 + fr] * (1.f / D) + EPS);
#pragma unroll
            for (int n = 0; n < 2; ++n) {
                const int c0 = cu0 + 4 * n;
                const f32x4 w0 = *(const f32x4*)(wcf + c0), w1 = *(const f32x4*)(wcf + DFF + c0), w2 = *(const f32x4*)(wcf + 2 * DFF + c0), bb = *(const f32x4*)(bcf + c0);
                float act[4][4];
#pragma unroll
                for (int j = 0; j < 4; ++j) {
                    float uv[4], gv[4], r1[4], r2[4];
#pragma unroll
                    for (int m = 0; m < 4; ++m) { uv[m] = acc[ai][0][m][n][j] * rs[m]; gv[m] = acc[ai][1][m][n][j] * rs[m]; r1[m] = dpp_f<0x121>(uv[m]); r2[m] = dpp_f<0x122>(uv[m]); }
#pragma unroll
                    for (int m = 0; m < 4; ++m) {
                        const float p1 = fr >= 1 ? r1[m] : (m > 0 ? r1[m > 0 ? m - 1 : 0] : 0.f);
                        const float p2 = fr >= 2 ? r2[m] : (m > 0 ? r2[m > 0 ? m - 1 : 0] : 0.f);
                        act[m][j] = gelu_tanh(w0[j] * p2 + w1[j] * p1 + w2[j] * uv[m] + bb[j]) * gv[m];
                    }
                    if (fr >= 14) HALO[(size_t)(blk * 2 + fr - 14) * DFF + c0 + j] = (bf16_t)f2bf(uv[3]);
                    if (fr < 2) { FIXU[(size_t)(blk * 2 + fr) * DFF + c0 + j] = (bf16_t)f2bf(uv[0]); FIXG[(size_t)(blk * 2 + fr) * DFF + c0 + j] = (bf16_t)f2bf(gv[0]); }
                }
#pragma unroll
                for (int m = 0; m < 4; ++m)
                    if (m > 0 || fr >= 2) { u32x2 w; w.x = pk2(act[m][0], act[m][1]); w.y = pk2(act[m][2], act[m][3]); *(u32x2*)(ACT + (size_t)(rowb + m * 16 + fr) * DFF + c0) = w; }
            }
        }
    }
};
__device__ __forceinline__ void p_fix(const Params& p) {
    const bf16_t* HALO = (const bf16_t*)(p.ws + WS_HALO); const bf16_t* FIXU = (const bf16_t*)(p.ws + WS_FIXU); const bf16_t* FIXG = (const bf16_t*)(p.ws + WS_FIXG);
    const bf16_t* RAWU = (const bf16_t*)(p.ws + WS_RAWU); const bf16_t* RAWG = (const bf16_t*)(p.ws + WS_RAWG); bf16_t* ACT = (bf16_t*)(p.ws + WS_GF);
    const float* wf = p.in[I_WCF]; const float* bfc = p.in[I_BCF];
    const int gt = blockIdx.x * NTHR + threadIdx.x, NGT = gridDim.x * NTHR;
    constexpr int NC8 = DFF / 8, N1 = 256 * NC8, N2 = NB * NC8, N3 = NDEC * NC8;
    for (int wi = gt; wi < N1 + N2 + N3; wi += NGT) {
        const int c8 = wi % NC8, col = 8 * c8; int q = wi / NC8;
        float w0[8], w1[8], w2[8], bb[8];
#pragma unroll
        for (int e = 0; e < 8; ++e) { w0[e] = wf[col + e]; w1[e] = wf[DFF + col + e]; w2[e] = wf[2 * DFF + col + e]; bb[e] = bfc[col + e]; }
        if (q < 256) {
            const int j = q; float p2[8], p1[8], u0[8], u1[8], g0[8], g1[8], o[8];
            if (j & 31) { unpack8(*(const u32x4*)(HALO + (size_t)(2 * (j - 1)) * DFF + col), p2); unpack8(*(const u32x4*)(HALO + (size_t)(2 * (j - 1) + 1) * DFF + col), p1); }
            else { const int b = j >> 5; unpack8(*(const u32x4*)(RAWU + (size_t)(16 * b + 14) * DFF + col), p2); unpack8(*(const u32x4*)(RAWU + (size_t)(16 * b + 15) * DFF + col), p1); }
            unpack8(*(const u32x4*)(FIXU + (size_t)(2 * j) * DFF + col), u0); unpack8(*(const u32x4*)(FIXU + (size_t)(2 * j + 1) * DFF + col), u1);
            unpack8(*(const u32x4*)(FIXG + (size_t)(2 * j) * DFF + col), g0); unpack8(*(const u32x4*)(FIXG + (size_t)(2 * j + 1) * DFF + col), g1);
#pragma unroll
            for (int e = 0; e < 8; ++e) o[e] = gelu_tanh(w0[e] * p2[e] + w1[e] * p1[e] + w2[e] * u0[e] + bb[e]) * g0[e];
            *(u32x4*)(ACT + (size_t)(64 * j) * DFF + col) = pack8(o);
#pragma unroll
            for (int e = 0; e < 8; ++e) o[e] = gelu_tanh(w0[e] * p1[e] + w1[e] * u0[e] + w2[e] * u1[e] + bb[e]) * g1[e];
            *(u32x4*)(ACT + (size_t)(64 * j + 1) * DFF + col) = pack8(o);
            if ((j & 31) == 31) {
                float h0[8], h1[8]; unpack8(*(const u32x4*)(HALO + (size_t)(2 * j) * DFF + col), h0); unpack8(*(const u32x4*)(HALO + (size_t)(2 * j + 1) * DFF + col), h1);
                float* so = p.out + O_FCP + (size_t)((j >> 5) * 2) * DFF + col;
#pragma unroll
                for (int e = 0; e < 8; ++e) { so[e] = h0[e]; so[DFF + e] = h1[e]; }
            }
        } else if (q < 256 + NB) {
            const int b = q - 256; float p2[8], p1[8];
#pragma unroll
            for (int e = 0; e < 8; ++e) { p2[e] = 0.f; p1[e] = 0.f; }
            for (int t = 0; t < 16; ++t) {
                const int lr = 16 * b + t; float uu[8], g[8], o[8];
                unpack8(*(const u32x4*)(RAWU + (size_t)lr * DFF + col), uu); unpack8(*(const u32x4*)(RAWG + (size_t)lr * DFF + col), g);
#pragma unroll
                for (int e = 0; e < 8; ++e) { o[e] = gelu_tanh(w0[e] * p2[e] + w1[e] * p1[e] + w2[e] * uu[e] + bb[e]) * g[e]; p2[e] = p1[e]; p1[e] = uu[e]; }
                *(u32x4*)(ACT + (size_t)(RMETA0 + lr) * DFF + col) = pack8(o);
            }
        } else {
            const int n = q - 256 - NB, lr = 128 + n; float uu[8], g[8], o[8];
            const float* s0 = p.in[I_SFC] + (size_t)n * 2 * DFF + col; const float* s1 = s0 + DFF;
            unpack8(*(const u32x4*)(RAWU + (size_t)lr * DFF + col), uu); unpack8(*(const u32x4*)(RAWG + (size_t)lr * DFF + col), g);
            float* so = p.out + O_FCS + (size_t)n * 2 * DFF + col;
#pragma unroll
            for (int e = 0; e < 8; ++e) { o[e] = gelu_tanh(w0[e] * s0[e] + w1[e] * s1[e] + w2[e] * uu[e] + bb[e]) * g[e]; so[e] = s1[e]; so[DFF + e] = uu[e]; }
            *(u32x4*)(ACT + (size_t)(RDEC0 + n) * DFF + col) = pack8(o);
        }
    }
}

template <class F, bool SKIP_META = false> __device__ __forceinline__ void thin_gemm(LAS unsigned char* lds, const bf16_t* A, const bf16_t* Bt, int K, int N, int row0, const F& f) {
    const int tid = threadIdx.x, lane = tid & 63, wave = tid >> 6, fr = lane & 15, fq = lane >> 4;
    LAS float* red = (LAS float*)lds;
    const int nct = N / 32, ntiles = 8 * nct, nks = K / 32;
    for (int tile = blockIdx.x; tile < ntiles; tile += gridDim.x) {
        const int rt = tile & 7, ct = tile >> 3;
        if (SKIP_META && rt < 4) continue;
        f32x4 acc[2][2];
#pragma unroll
        for (int i = 0; i < 2; ++i)
#pragma unroll
            for (int j = 0; j < 2; ++j) acc[i][j] = (f32x4){0.f, 0.f, 0.f, 0.f};
        const bf16_t* ap = A + (size_t)(row0 + rt * 32 + fr) * K + 8 * fq;
        const bf16_t* bp = Bt + (size_t)(ct * 32 + fr) * K + 8 * fq;
        const int per = (nks + 7) >> 3, ks0 = wave * per, ks1 = (ks0 + per < nks) ? ks0 + per : nks;
        for (int kb = ks0; kb < ks1; kb += 6) {
            bf16x8 a0[6], a1[6], b0[6], b1[6];
#pragma unroll
            for (int u = 0; u < 6; ++u) if (kb + u < ks1) { const int ks = kb + u;
                a0[u] = *(const bf16x8*)(ap + ks * 32); a1[u] = *(const bf16x8*)(ap + (size_t)16 * K + ks * 32);
                b0[u] = *(const bf16x8*)(bp + ks * 32); b1[u] = *(const bf16x8*)(bp + (size_t)16 * K + ks * 32); }
#pragma unroll
            for (int u = 0; u < 6; ++u) if (kb + u < ks1) {
                acc[0][0] = MFMA16(b0[u], a0[u], acc[0][0]); acc[0][1] = MFMA16(b1[u], a0[u], acc[0][1]);
                acc[1][0] = MFMA16(b0[u], a1[u], acc[1][0]); acc[1][1] = MFMA16(b1[u], a1[u], acc[1][1]); }
        }
        lds_barrier();
#pragma unroll
        for (int i = 0; i < 2; ++i)
#pragma unroll
            for (int j = 0; j < 2; ++j)
#pragma unroll
                for (int r = 0; r < 4; ++r) red[wave * 1056 + (16 * i + fr) * 33 + 16 * j + 4 * fq + r] = acc[i][j][r];
        lds_barrier();
        if (tid < 128) {
            const int rr = tid >> 2, c8 = tid & 3; float v[8];
#pragma unroll
            for (int e = 0; e < 8; ++e) { float s = 0.f;
#pragma unroll
                for (int w = 0; w < 8; ++w) s += red[w * 1056 + rr * 33 + c8 * 8 + e];
                v[e] = s; }
            const int row = row0 + rt * 32 + rr;
            const float ss = f(row, ct * 32 + c8 * 8, (f32x4){v[0], v[1], v[2], v[3]}, (f32x4){v[4], v[5], v[6], v[7]}, f.pre(row, ct * 32 + c8 * 8));
            if (F::HAS_SS) f.add_ss(row, ss);
        }
    }
    lds_barrier();
}

constexpr int SQ = 136, SK = 72, SM_ = 68;
constexpr int L_QS = 0, L_KS = L_QS + 64 * SQ * 2, L_KBS = L_KS + 64 * SQ * 2, L_VBT = L_KBS + 64 * SQ * 2, L_KGT = L_VBT + 64 * SQ * 2,
              L_MF = L_KGT + 64 * SQ * 2, L_TF = L_MF + 64 * SM_ * 4, L_TB = L_TF + 64 * SM_ * 4, L_G = L_TB + 64 * SK * 2, L_P = L_G + 1024, L_END2 = L_P + 2 * 16 * 17 * 4 + 1536 * 4;
static_assert(L_END2 <= LDS_BYTES, "P2 LDS");

__device__ __forceinline__ void p2_delta_item(const Params& p, LAS unsigned char* lds, int item) {
    int tid_ = threadIdx.x; asm volatile("" : "+v"(tid_));
    const int tid = tid_, lane = tid & 63, wave = tid >> 6, fr = lane & 15, fq = lane >> 4;
    const int c = item % NCH, bh = item / NCH, h = bh & 3, b = bh >> 2;
    unsigned char* ws = p.ws;
    const bf16_t* PA = (const bf16_t*)(ws + WS_PROJA);
    const float* SMALL = (const float*)((unsigned char*)p.out + DS_SMALL);
    LAS bf16_t* qs = (LAS bf16_t*)(lds + L_QS); LAS bf16_t* ks = (LAS bf16_t*)(lds + L_KS); LAS bf16_t* kbs = (LAS bf16_t*)(lds + L_KBS);
    LAS bf16_t* vbT = (LAS bf16_t*)(lds + L_VBT); LAS bf16_t* kgT = (LAS bf16_t*)(lds + L_KGT);
    LAS float* Mf = (LAS float*)(lds + L_MF); LAS float* Tf = (LAS float*)(lds + L_TF); LAS bf16_t* Tb = (LAS bf16_t*)(lds + L_TB);
    LAS float* gs = (LAS float*)(lds + L_G); LAS float* Gs = gs + 64; LAS float* Pf = (LAS float*)(lds + L_P);
    const int i = tid >> 3, cgp = tid & 7;
    const int row = prow(b, c, i);
    u32x4 xo[3][2], xh[3][2];
    const int hrow = tid < 24 ? prow(b, c, (tid >> 3) - 3) : -1;
#pragma unroll
    for (int sel = 0; sel < 3; ++sel) {
        if (row >= 0) { const u32x4* xp = (const u32x4*)(PA + (size_t)row * LDA_ + sel * 512 + h * 128 + 16 * cgp); xo[sel][0] = xp[0]; xo[sel][1] = xp[1]; }
        else { xo[sel][0] = (u32x4){0u, 0u, 0u, 0u}; xo[sel][1] = (u32x4){0u, 0u, 0u, 0u}; }
        if (hrow >= 0) { const u32x4* xp = (const u32x4*)(PA + (size_t)hrow * LDA_ + sel * 512 + h * 128 + 16 * cgp); xh[sel][0] = xp[0]; xh[sel][1] = xp[1]; }
        else { xh[sel][0] = (u32x4){0u, 0u, 0u, 0u}; xh[sel][1] = (u32x4){0u, 0u, 0u, 0u}; }
    }
    LAS bf16_t* xs = (LAS bf16_t*)(lds + L_MF);
    float sb_ = 0.f, sa_ = 0.f;
    if (row >= 0) { sb_ = SMALL[(size_t)row * 32 + h]; sa_ = SMALL[(size_t)row * 32 + 4 + h]; }
    LAS float* wcs = (LAS float*)(lds + L_P + 2 * 16 * 17 * 4);
    for (int e = tid; e < 1536; e += NTHR) { const int j = e / 384, r = e % 384; wcs[e] = p.in[I_WCA][j * CA + (r >> 7) * 512 + h * 128 + (r & 127)]; }
    float beta = 0.f, g = 0.f;
    if (row >= 0) { beta = sigmoidf_(sb_); g = -__expf(p.in[I_ALOG][h]) * softplusf_(sa_ + p.in[I_DTB][h]); }
    if (cgp == 0) gs[i] = g;
    lds_barrier();
    if (wave == 0) {
        Gs[lane] = wave_incl_scan(gs[lane]);
    }
    lds_barrier();
    const float Gi = Gs[i], Gl = Gs[63];
    const float eg = __expf(Gi), egl = __expf(Gl - Gi);
    if (tid == 0) ((float*)((unsigned char*)p.out + DS_EGL))[item] = __expf(Gl);
#pragma unroll
    for (int sel = 0; sel < 3; ++sel) {
        if (sel > 0) lds_barrier();
        *(LAS u32x4*)(xs + (i + 3) * SQ + 16 * cgp) = xo[sel][0]; *(LAS u32x4*)(xs + (i + 3) * SQ + 16 * cgp + 8) = xo[sel][1];
        if (tid < 24) { *(LAS u32x4*)(xs + (tid >> 3) * SQ + 16 * cgp) = xh[sel][0]; *(LAS u32x4*)(xs + (tid >> 3) * SQ + 16 * cgp + 8) = xh[sel][1]; }
        lds_barrier();
        float y[16];
#pragma unroll
        for (int e = 0; e < 16; ++e) y[e] = 0.f;
#pragma unroll
        for (int j = 0; j < 4; ++j) {
            float x[16]; unpack8(*(const LAS u32x4*)(xs + (i + j) * SQ + 16 * cgp), x); unpack8(*(const LAS u32x4*)(xs + (i + j) * SQ + 16 * cgp + 8), x + 8);
            const LAS f32x4* wc = (const LAS f32x4*)(wcs + j * 384 + sel * 128 + 16 * cgp);
#pragma unroll
            for (int e4 = 0; e4 < 4; ++e4) { const f32x4 w = wc[e4]; y[4 * e4] += w.x * x[4 * e4]; y[4 * e4 + 1] += w.y * x[4 * e4 + 1]; y[4 * e4 + 2] += w.z * x[4 * e4 + 2]; y[4 * e4 + 3] += w.w * x[4 * e4 + 3]; }
            if (j == 3 && c == NCH - 1 && i >= 61) {
                f32x4* o = (f32x4*)(p.out + O_DCP + (size_t)(b * 3 + (i - 61)) * CA + sel * 512 + h * 128 + 16 * cgp);
#pragma unroll
                for (int e4 = 0; e4 < 4; ++e4) o[e4] = (f32x4){x[4 * e4], x[4 * e4 + 1], x[4 * e4 + 2], x[4 * e4 + 3]};
            }
        }
        float ss = 0.f;
#pragma unroll
        for (int e = 0; e < 16; ++e) { y[e] = siluf_(y[e]); ss += y[e] * y[e]; }
        ss += __shfl_xor(ss, 1); ss += __shfl_xor(ss, 2); ss += __shfl_xor(ss, 4);
        float t[16];
        if (sel == 0) {
            const float rq = rsqrtf(ss + EPS) * 0.08838834764831845f;
#pragma unroll
            for (int e = 0; e < 16; ++e) y[e] *= rq;
            *(LAS u32x4*)(qs + i * SQ + 16 * cgp) = pack8(y); *(LAS u32x4*)(qs + i * SQ + 16 * cgp + 8) = pack8(y + 8);
            if (row >= 0) {
#pragma unroll
                for (int e = 0; e < 16; ++e) t[e] = y[e] * eg;
                u32x4* o = (u32x4*)((bf16_t*)(ws + WS_QT) + (size_t)row * 512 + h * 128 + 16 * cgp); o[0] = pack8(t); o[1] = pack8(t + 8);
            }
        } else if (sel == 1) {
            const float rk = rsqrtf(ss + EPS);
#pragma unroll
            for (int e = 0; e < 16; ++e) y[e] *= rk;
            *(LAS u32x4*)(ks + i * SQ + 16 * cgp) = pack8(y); *(LAS u32x4*)(ks + i * SQ + 16 * cgp + 8) = pack8(y + 8);
            if (row >= 0) {
#pragma unroll
                for (int e = 0; e < 16; ++e) t[e] = y[e] * egl;
                u32x4* o = (u32x4*)((bf16_t*)(ws + WS_KT) + (size_t)row * 512 + h * 128 + 16 * cgp); o[0] = pack8(t); o[1] = pack8(t + 8);
            }
#pragma unroll
            for (int e = 0; e < 16; ++e) t[e] = y[e] * beta;
            *(LAS u32x4*)(kbs + i * SQ + 16 * cgp) = pack8(t); *(LAS u32x4*)(kbs + i * SQ + 16 * cgp + 8) = pack8(t + 8);
#pragma unroll
            for (int e = 0; e < 16; ++e) t[e] *= eg;
            *(LAS u32x4*)(kgT + i * SQ + 16 * cgp) = pack8(t); *(LAS u32x4*)(kgT + i * SQ + 16 * cgp + 8) = pack8(t + 8);
        } else {
#pragma unroll
            for (int e = 0; e < 16; ++e) t[e] = y[e] * beta;
            *(LAS u32x4*)(vbT + i * SQ + 16 * cgp) = pack8(t); *(LAS u32x4*)(vbT + i * SQ + 16 * cgp + 8) = pack8(t + 8);
        }
    }
    lds_barrier();
#pragma unroll 1
    for (int id = wave * 4; id < wave * 4 + 4; ++id) {
        const int which = id >> 4, ti = (id & 15) >> 2, tj = id & 3;
        if (tj > ti) {
            if (which == 0) { *(LAS f32x4*)(Mf + (16 * ti + fr) * SM_ + 16 * tj + 4 * fq) = (f32x4){0.f, 0.f, 0.f, 0.f}; }
            else { *(u32x2*)((bf16_t*)(ws + WS_ATTA) + (size_t)item * 4096 + (16 * ti + fr) * 64 + 16 * tj + 4 * fq) = (u32x2){0u, 0u}; }
            continue;
        }
        f32x4 acc = {0.f, 0.f, 0.f, 0.f};
        const LAS bf16_t* ya = which == 0 ? kbs : qs;
#pragma unroll
        for (int k0 = 0; k0 < 128; k0 += 32) acc = MFMA16(lfrag(ks, 16 * tj + fr, SQ, k0, fq), lfrag(ya, 16 * ti + fr, SQ, k0, fq), acc);
        const int ii = 16 * ti + fr, j0 = 16 * tj + 4 * fq;
        const float gi = Gs[ii];
        float o[4];
#pragma unroll
        for (int r = 0; r < 4; ++r) { const int jj = j0 + r; const bool keep = which == 0 ? (ii > jj) : (ii >= jj); o[r] = keep ? acc[r] * __expf(gi - Gs[jj]) : 0.f; }
        if (which == 0) *(LAS f32x4*)(Mf + ii * SM_ + j0) = (f32x4){o[0], o[1], o[2], o[3]};
        else { u32x2 w; w.x = pk2(o[0], o[1]); w.y = pk2(o[2], o[3]); *(u32x2*)((bf16_t*)(ws + WS_ATTA) + (size_t)item * 4096 + ii * 64 + j0) = w; }
    }
    lds_barrier();
    if (tid < 64) {
        const int blk = tid >> 4, j = tid & 15; float x[16];
#pragma unroll
        for (int r = 0; r < 16; ++r) {
            float s = (r == j) ? 1.f : 0.f;
#pragma unroll
            for (int m4 = 0; m4 < 4; ++m4) if (4 * m4 < r) { const f32x4 mv = *(const LAS f32x4*)(Mf + (16 * blk + r) * SM_ + 16 * blk + 4 * m4);
                if (4 * m4 < r) s -= mv.x * x[4 * m4]; if (4 * m4 + 1 < r) s -= mv.y * x[4 * m4 + 1]; if (4 * m4 + 2 < r) s -= mv.z * x[4 * m4 + 2]; if (4 * m4 + 3 < r) s -= mv.w * x[4 * m4 + 3]; }
            x[r] = s;
            asm volatile("" ::: "memory");
        }
#pragma unroll
        for (int r = 0; r < 16; ++r) Tf[(16 * blk + r) * SM_ + 16 * blk + j] = x[r];
    }
    lds_barrier();
#pragma unroll 1
    for (int dlev = 1; dlev < 4; ++dlev)
#pragma unroll 1
        for (int b0 = 0; b0 < 4 - dlev; b0 += 2) {
            const int half = tid >> 8, bj = b0 + half, bi = dlev + bj; const bool active = bj < 4 - dlev;
            const int t2 = tid & 255, r = t2 >> 4, cc = t2 & 15; LAS float* Pf2 = Pf + half * 272;
            if (active) {
                float s = 0.f;
#pragma unroll 1
                for (int kb = bj; kb < bi; ++kb)
#pragma unroll
                    for (int m4 = 0; m4 < 4; ++m4) { const f32x4 mv = *(const LAS f32x4*)(Mf + (16 * bi + r) * SM_ + 16 * kb + 4 * m4);
                        s += mv.x * Tf[(16 * kb + 4 * m4) * SM_ + 16 * bj + cc] + mv.y * Tf[(16 * kb + 4 * m4 + 1) * SM_ + 16 * bj + cc]
                           + mv.z * Tf[(16 * kb + 4 * m4 + 2) * SM_ + 16 * bj + cc] + mv.w * Tf[(16 * kb + 4 * m4 + 3) * SM_ + 16 * bj + cc]; }
                Pf2[r * 17 + cc] = s;
            }
            lds_barrier();
            if (active) {
                float s = 0.f;
#pragma unroll
                for (int m4 = 0; m4 < 4; ++m4) { const f32x4 tv = *(const LAS f32x4*)(Tf + (16 * bi + r) * SM_ + 16 * bi + 4 * m4);
                    s += tv.x * Pf2[(4 * m4) * 17 + cc] + tv.y * Pf2[(4 * m4 + 1) * 17 + cc] + tv.z * Pf2[(4 * m4 + 2) * 17 + cc] + tv.w * Pf2[(4 * m4 + 3) * 17 + cc]; }
                Tf[(16 * bi + r) * SM_ + 16 * bj + cc] = -s;
            }
            lds_barrier();
        }
    {
        const int r = tid >> 3, c0 = (tid & 7) * 8; float t[8];
#pragma unroll
        for (int e = 0; e < 8; ++e) { const int cc = c0 + e; t[e] = ((cc >> 4) <= (r >> 4)) ? Tf[r * SM_ + cc] : 0.f; if ((cc >> 4) == (r >> 4) && cc > r) t[e] = 0.f; }
        *(LAS u32x4*)(Tb + r * SK + c0) = pack8(t);
    }
    lds_barrier();
#pragma unroll 1
    for (int id = wave * 8; id < wave * 8 + 8; ++id) {
        const int which = id >> 5, ti = (id & 31) >> 3, te = id & 7;
        const LAS bf16_t* xa = which == 0 ? vbT : kgT;
        f32x4 acc = {0.f, 0.f, 0.f, 0.f};
#pragma unroll
        for (int k0 = 0; k0 < 64; k0 += 32) acc = MFMA16(trfrag(xa, SQ, k0, 16 * te, fr, fq), lfrag(Tb, 16 * ti + fr, SK, k0, fq), acc);
        const int ri = prow(b, c, 16 * ti + fr);
        if (ri >= 0) { u32x2 w; w.x = pk2(acc[0], acc[1]); w.y = pk2(acc[2], acc[3]);
            *(u32x2*)((bf16_t*)(ws + (which == 0 ? WS_UU : WS_WW)) + (size_t)ri * 512 + h * 128 + 16 * te + 4 * fq) = w; }
    }
    lds_barrier();
}

__device__ __forceinline__ void p2_gla_item(const Params& p, LAS unsigned char* lds, int item) {
    int tid_ = threadIdx.x; asm volatile("" : "+v"(tid_));
    const int tid = tid_, lane = tid & 63, wave = tid >> 6, fr = lane & 15, fq = lane >> 4;
    const int c = item % NCH, bh = item / NCH, h = bh & 3, b = bh >> 2;
    unsigned char* ws = p.ws;
    bf16_t* PA = (bf16_t*)(ws + WS_PROJA);
    const float* SMALL = (const float*)((unsigned char*)p.out + DS_SMALL);
    LAS bf16_t* qs = (LAS bf16_t*)(lds + L_QS); LAS bf16_t* ks = (LAS bf16_t*)(lds + L_KS);
    const int i = lane, row = prow(b, c, i), d0 = 16 * wave;
    LAS float* W2s = (LAS float*)(lds + L_MF);
    f32x4 lrv[4]; u32x4 qraw[2], kraw[2];
    if (row >= 0) {
        const f32x4* lp = (const f32x4*)(SMALL + (size_t)row * 32 + 8);
#pragma unroll
        for (int j = 0; j < 4; ++j) lrv[j] = lp[j];
        const u32x4* qp = (const u32x4*)(PA + (size_t)row * LDA_ + 1536 + h * 128 + d0);
        qraw[0] = qp[0]; qraw[1] = qp[1]; qraw[0] = qp[0]; kraw[0] = qp[64]; kraw[1] = qp[65];
    }
    {
        float wv[4];
#pragma unroll
        for (int u = 0; u < 4; ++u) { const int e = tid + u * NTHR; wv[u] = p.in[I_WGK2][(e >> 7) * 512 + h * 128 + (e & 127)]; }
        const float bv = tid < 128 ? p.in[I_BGK][h * 128 + tid] : 0.f;
#pragma unroll
        for (int u = 0; u < 4; ++u) W2s[tid + u * NTHR] = wv[u];
        if (tid < 128) W2s[2048 + tid] = bv;
    }
    lds_barrier();
    float bc[16];
    if (row >= 0) {
        float lr[16];
#pragma unroll
        for (int j = 0; j < 4; ++j) { const f32x4 t = lrv[j]; lr[4 * j] = t.x; lr[4 * j + 1] = t.y; lr[4 * j + 2] = t.z; lr[4 * j + 3] = t.w; }
#pragma unroll
        for (int e = 0; e < 16; ++e) bc[e] = W2s[2048 + d0 + e];
#pragma unroll
        for (int r = 0; r < 16; ++r) {
#pragma unroll
            for (int e4 = 0; e4 < 4; ++e4) { const f32x4 w = *(const LAS f32x4*)(W2s + r * 128 + d0 + 4 * e4);
                bc[4 * e4] += lr[r] * w.x; bc[4 * e4 + 1] += lr[r] * w.y; bc[4 * e4 + 2] += lr[r] * w.z; bc[4 * e4 + 3] += lr[r] * w.w; }
        }
#pragma unroll
        for (int e = 0; e < 16; ++e) bc[e] = -softplusf_(-bc[e]) * (1.f / 16.f);
    } else {
#pragma unroll
        for (int e = 0; e < 16; ++e) bc[e] = 0.f;
    }
#pragma unroll
    for (int e = 0; e < 16; ++e) bc[e] = wave_incl_scan(bc[e]);
    if (lane == 63) { float* eb = (float*)((unsigned char*)p.out + DS_EBL) + (size_t)item * 128 + d0;
#pragma unroll
        for (int e = 0; e < 16; ++e) eb[e] = __expf(bc[e]); }
    float qv[16], kv[16];
    if (row >= 0) {
        unpack8(qraw[0], qv); unpack8(qraw[1], qv + 8); unpack8(kraw[0], kv); unpack8(kraw[1], kv + 8);
#pragma unroll
        for (int e = 0; e < 16; ++e) { qv[e] *= __expf(bc[e]) * 0.08838834764831845f; kv[e] *= __expf(-bc[e]); }
        u32x4* qp = (u32x4*)(PA + (size_t)row * LDA_ + 1536 + h * 128 + d0);
        qp[0] = pack8(qv); qp[1] = pack8(qv + 8); qp[64] = pack8(kv); qp[65] = pack8(kv + 8);
    } else {
#pragma unroll
        for (int e = 0; e < 16; ++e) { qv[e] = 0.f; kv[e] = 0.f; }
    }
    *(LAS u32x4*)(qs + i * SQ + d0) = pack8(qv); *(LAS u32x4*)(qs + i * SQ + d0 + 8) = pack8(qv + 8);
    *(LAS u32x4*)(ks + i * SQ + d0) = pack8(kv); *(LAS u32x4*)(ks + i * SQ + d0 + 8) = pack8(kv + 8);
    lds_barrier();
    bf16_t* ATT = (bf16_t*)((unsigned char*)p.out + DS_ATTB) + (size_t)item * 4096;
#pragma unroll 1
    for (int id = wave * 2; id < wave * 2 + 2; ++id) {
        const int ti = id >> 2, tj = id & 3;
        const int ii = 16 * ti + fr, j0 = 16 * tj + 4 * fq;
        if (tj > ti) { *(u32x2*)(ATT + ii * 64 + j0) = (u32x2){0u, 0u}; continue; }
        f32x4 acc = {0.f, 0.f, 0.f, 0.f};
#pragma unroll
        for (int k0 = 0; k0 < 128; k0 += 32) acc = MFMA16(lfrag(ks, 16 * tj + fr, SQ, k0, fq), lfrag(qs, 16 * ti + fr, SQ, k0, fq), acc);
        float o[4];
#pragma unroll
        for (int r = 0; r < 4; ++r) o[r] = (ii >= j0 + r) ? acc[r] : 0.f;
        u32x2 w; w.x = pk2(o[0], o[1]); w.y = pk2(o[2], o[3]); *(u32x2*)(ATT + ii * 64 + j0) = w;
    }
    lds_barrier();
}

struct DDPre { float s0, s1, s2, xn, sb, sa; };
__device__ __forceinline__ void dd_load(const Params& p, int item, float (&S)[32], DDPre& q) {
    const int tid = threadIdx.x, n = item >> 2, h = item & 3, row = RDEC0 + n;
    const int e = tid & 127, kq = tid >> 7;
    const float* Sp = p.in[I_SD] + ((size_t)item * 128 + 32 * kq) * 128 + e;
#pragma unroll
    for (int k = 0; k < 32; ++k) S[k] = Sp[(size_t)k * 128];
    const float* SMALL = (const float*)((unsigned char*)p.out + DS_SMALL);
    q.sb = SMALL[(size_t)row * 32 + h]; q.sa = SMALL[(size_t)row * 32 + 4 + h];
    q.s0 = q.s1 = q.s2 = q.xn = 0.f;
    if (tid < 384) {
        const int sel = tid >> 7, chl = tid & 127, ch = sel * 512 + h * 128 + chl;
        const float* st = p.in[I_SDC] + (size_t)n * 3 * CA + ch;
        q.s0 = st[0]; q.s1 = st[CA]; q.s2 = st[2 * CA]; q.xn = bf2f(((const bf16_t*)(p.ws + WS_PROJA))[(size_t)row * LDA_ + ch]);
    }
}
__device__ __forceinline__ void dd_compute(const Params& p, LAS unsigned char* lds, int item, float (&S)[32], const DDPre& q) {
    const int tid = threadIdx.x, lane = tid & 63, wave = tid >> 6;
    const int n = item >> 2, h = item & 3, row = RDEC0 + n;
    LAS float* vals = (LAS float*)lds;
    LAS float* part = vals + 384;
    LAS float* red = part + 8;
    const int e = tid & 127, kq = tid >> 7;
    float y = 0.f;
    if (tid < 384) {
        const int sel = tid >> 7, chl = tid & 127, ch = sel * 512 + h * 128 + chl;
        const float* wc = p.in[I_WCA] + ch;
        y = siluf_(wc[0] * q.s0 + wc[CA] * q.s1 + wc[2 * CA] * q.s2 + wc[3 * CA] * q.xn);
        float* o = p.out + O_DCS + (size_t)n * 3 * CA + ch; o[0] = q.s1; o[CA] = q.s2; o[2 * CA] = q.xn;
        vals[tid] = y;
    }
    const float ws_ = wave_sum(y * y);
    if (lane == 0) part[wave] = ws_;
    lds_barrier();
    const float rq = rsqrtf(part[0] + part[1] + EPS) * 0.08838834764831845f, rk = rsqrtf(part[2] + part[3] + EPS);
    const float beta = sigmoidf_(q.sb);
    const float eg = __expf(-__expf(p.in[I_ALOG][h]) * softplusf_(q.sa + p.in[I_DTB][h]));
    float pe = 0.f;
#pragma unroll
    for (int k = 0; k < 32; ++k) { S[k] *= eg; pe += vals[128 + 32 * kq + k] * rk * S[k]; }
    red[kq * 128 + e] = pe;
    lds_barrier();
    const float err = (vals[256 + e] - (red[e] + red[128 + e] + red[256 + e] + red[384 + e])) * beta;
    lds_barrier();
    float* So = p.out + O_DS + ((size_t)item * 128 + 32 * kq) * 128 + e; float po = 0.f;
#pragma unroll
    for (int k = 0; k < 32; ++k) { const float sv = S[k] + vals[128 + 32 * kq + k] * rk * err; So[(size_t)k * 128] = sv; po += vals[32 * kq + k] * rq * sv; }
    red[kq * 128 + e] = po;
    lds_barrier();
    {
        float* sso = (float*)((unsigned char*)p.out + DS_SSO) + ((size_t)row * 8 + h) * 8;
        float ov = 0.f;
        if (tid < 128) { ov = red[e] + red[128 + e] + red[256 + e] + red[384 + e]; ((bf16_t*)((unsigned char*)p.out + DS_OA))[(size_t)row * 512 + h * 128 + e] = (bf16_t)f2bf(ov); }
        const float sq = wave_sum(ov * ov);
        if (lane == 0) sso[wave] = sq;
    }
    lds_barrier();
}
struct DGPre { float lr, w[16], bg, qx, kx, vx; };
__device__ __forceinline__ void dg_load(const Params& p, int item, float (&S)[64], DGPre& q) {
    const int tid = threadIdx.x, n = item >> 2, h = item & 3, row = RDEC0 + n;
    const int e = tid & 255, kh = tid >> 8;
    const float* Sp = p.in[I_SG] + ((size_t)item * 128 + 64 * kh) * 256 + e;
#pragma unroll
    for (int k = 0; k < 64; ++k) S[k] = Sp[(size_t)k * 256];
    const bf16_t* PA = (const bf16_t*)(p.ws + WS_PROJA);
    q.vx = bf2f(PA[(size_t)row * LDA_ + 2560 + h * 256 + e]);
    q.qx = q.kx = q.bg = 0.f;
    if (tid < 128) { q.qx = bf2f(PA[(size_t)row * LDA_ + 1536 + h * 128 + tid]); q.kx = bf2f(PA[(size_t)row * LDA_ + 2048 + h * 128 + tid]); q.bg = p.in[I_BGK][h * 128 + tid];
#pragma unroll
        for (int r = 0; r < 16; ++r) q.w[r] = p.in[I_WGK2][r * 512 + h * 128 + tid]; }
}
__device__ __forceinline__ void dg_compute(const Params& p, LAS unsigned char* lds, int item, float (&S)[64], const DGPre& q) {
    const int tid = threadIdx.x;
    const int n = item >> 2, h = item & 3, row = RDEC0 + n;
    const float* SMALL = (const float*)((unsigned char*)p.out + DS_SMALL);
    LAS float* qv = (LAS float*)lds; LAS float* kv = qv + 128; LAS float* dv = kv + 128; LAS float* red = dv + 128;
    const int e = tid & 255, kh = tid >> 8;
    if (tid < 128) {
        float x = q.bg;
#pragma unroll
        for (int r = 0; r < 16; ++r) x += SMALL[(size_t)row * 32 + 8 + r] * q.w[r];
        dv[tid] = __expf(-softplusf_(-x) * (1.f / 16.f));
        qv[tid] = q.qx * 0.08838834764831845f;
        kv[tid] = q.kx;
    }
    lds_barrier();
    const float ve = q.vx;
    float* So = p.out + O_GS + ((size_t)item * 128 + 64 * kh) * 256 + e;
    float po = 0.f;
#pragma unroll
    for (int k = 0; k < 64; ++k) { const int kk = 64 * kh + k; const float sv = S[k] * dv[kk] + kv[kk] * ve; So[(size_t)k * 256] = sv; po += qv[kk] * sv; }
    red[kh * 256 + e] = po;
    lds_barrier();
    {
        float* sso = (float*)((unsigned char*)p.out + DS_SSO) + ((size_t)row * 8 + 4 + h) * 8;
        float ov = 0.f;
        if (tid < 256) { ov = red[e] + red[256 + e]; ((bf16_t*)(p.ws + WS_OB))[(size_t)row * 1024 + h * 256 + e] = (bf16_t)f2bf(ov); }
        const float sq = wave_sum(ov * ov);
        if ((tid & 63) == 0) sso[tid >> 6] = sq;
    }
    lds_barrier();
}
__device__ __forceinline__ void p3_decode(const Params& p, LAS unsigned char* lds) {
    const int G = gridDim.x, b0 = blockIdx.x;
    float Sd[32], Sg[64]; DDPre dq; DGPre gq;
    if (G == 256) {
        dd_load(p, b0, Sd, dq); dg_load(p, b0, Sg, gq);
        dd_compute(p, lds, b0, Sd, dq); dd_load(p, b0 + 256, Sd, dq);
        dg_compute(p, lds, b0, Sg, gq); dg_load(p, b0 + 256, Sg, gq);
        dd_compute(p, lds, b0 + 256, Sd, dq);
        dg_compute(p, lds, b0 + 256, Sg, gq);
    } else {
        for (int it = b0; it < NDEC * 4; it += G) { dd_load(p, it, Sd, dq); dd_compute(p, lds, it, Sd, dq); }
        for (int it = b0; it < NDEC * 4; it += G) { dg_load(p, it, Sg, gq); dg_compute(p, lds, it, Sg, gq); }
    }
}

constexpr int LD_WS = 0, LD_QS = LD_WS + 64 * SQ * 2, LD_AS = LD_QS + 64 * SQ * 2, LD_KT = LD_AS + 64 * SK * 2, LD_US = LD_KT + 64 * SQ * 2, LD_BUF = LD_US + 64 * 40 * 2,
              LD_ST = 2 * LD_BUF, LD_VN = LD_ST + 32 * SQ * 2, LD_ENDD = LD_VN + 32 * SK * 2;
static_assert(LD_ENDD <= LDS_BYTES - 64, "delta scan LDS");
struct DReg { u32x4 rw[2], rq[2], rk[2], ra, ru; float egl; };
struct DCtx { const bf16_t *QT, *KT, *WW, *UU, *ATT; const float* EGL; bf16_t* OA; float* SSO; const unsigned char* zero; const float* ones; unsigned char* junk; int b, h, bh, sl, tid, wave, fr, fq; };
__device__ __forceinline__ void delta_prefetch(const DCtx& x, DReg& r, int cc) {
    const bool live = cc < NCH;
    const bf16_t* zp = (const bf16_t*)(x.zero + (x.tid & 255) * 16);
#pragma unroll
    for (int s = 0; s < 2; ++s) { const int pi = x.tid + 512 * s, rr = pi >> 4, c8 = pi & 15; const int gr = live ? prow(x.b, cc, rr) : -1;
        const size_t off = (size_t)(gr >= 0 ? gr : 0) * 512 + x.h * 128 + 8 * c8;
        r.rw[s] = *(const u32x4*)(gr >= 0 ? x.WW + off : zp); r.rq[s] = *(const u32x4*)(gr >= 0 ? x.QT + off : zp); r.rk[s] = *(const u32x4*)(gr >= 0 ? x.KT + off : zp); }
    r.ra = *(const u32x4*)(live ? x.ATT + (size_t)(x.bh * NCH + cc) * 4096 + x.tid * 8 : zp);
    { const int t2 = x.tid & 255, rr = t2 >> 2, c8 = t2 & 3; const int gr = live ? prow(x.b, cc, rr) : -1;
      r.ru = *(const u32x4*)(gr >= 0 ? x.UU + (size_t)gr * 512 + x.h * 128 + 32 * x.sl + 8 * c8 : zp); }
    r.egl = *(live ? x.EGL + x.bh * NCH + cc : x.ones);
}
__device__ __forceinline__ void delta_stage(const DCtx& x, LAS unsigned char* buf, const DReg& r) {
    LAS bf16_t* Wsm = (LAS bf16_t*)(buf + LD_WS); LAS bf16_t* Qsm = (LAS bf16_t*)(buf + LD_QS); LAS bf16_t* Asm = (LAS bf16_t*)(buf + LD_AS);
    LAS bf16_t* KTs = (LAS bf16_t*)(buf + LD_KT); LAS bf16_t* Us = (LAS bf16_t*)(buf + LD_US);
    const int tid = x.tid;
#pragma unroll
    for (int s = 0; s < 2; ++s) { const int pi = tid + 512 * s, rr = pi >> 4, c8 = pi & 15;
        *(LAS u32x4*)(Wsm + rr * SQ + 8 * c8) = r.rw[s]; *(LAS u32x4*)(Qsm + rr * SQ + 8 * c8) = r.rq[s]; *(LAS u32x4*)(KTs + rr * SQ + 8 * c8) = r.rk[s]; }
    *(LAS u32x4*)(Asm + (tid >> 3) * SK + (tid & 7) * 8) = r.ra;
    *(LAS u32x4*)(Us + ((tid & 255) >> 2) * 40 + (tid & 3) * 8) = r.ru;
}
__device__ __forceinline__ void delta_compute(const DCtx& x, LAS unsigned char* lds, LAS unsigned char* buf, int c, float egl, f32x4 (&Sacc)[2]) {
    LAS bf16_t* Wsm = (LAS bf16_t*)(buf + LD_WS); LAS bf16_t* Qsm = (LAS bf16_t*)(buf + LD_QS); LAS bf16_t* Asm = (LAS bf16_t*)(buf + LD_AS);
    LAS bf16_t* KTs = (LAS bf16_t*)(buf + LD_KT); LAS bf16_t* Us = (LAS bf16_t*)(buf + LD_US); LAS bf16_t* St = (LAS bf16_t*)(lds + LD_ST); LAS bf16_t* VnT = (LAS bf16_t*)(lds + LD_VN);
    const int tid = x.tid, wave = x.wave, fr = x.fr, fq = x.fq, it = wave >> 1, et = wave & 1;
    f32x4 av = {0.f, 0.f, 0.f, 0.f}, ao = {0.f, 0.f, 0.f, 0.f};
#pragma unroll
    for (int k0 = 0; k0 < 128; k0 += 32) {
        const bf16x8 sf = lfrag(St, 16 * et + fr, SQ, k0, fq);
        av = MFMA16(lfrag(Wsm, 16 * it + fr, SQ, k0, fq), sf, av);
        ao = MFMA16(sf, lfrag(Qsm, 16 * it + fr, SQ, k0, fq), ao);
    }
    {
        const int ee = 16 * et + fr, i0 = 16 * it + 4 * fq; float vn[4];
#pragma unroll
        for (int q = 0; q < 4; ++q) vn[q] = bf2f(Us[(i0 + q) * 40 + ee]) - av[q];
        u32x2 w; w.x = pk2(vn[0], vn[1]); w.y = pk2(vn[2], vn[3]); *(LAS u32x2*)(VnT + ee * SK + i0) = w;
    }
    lds_barrier();
#pragma unroll
    for (int k0 = 0; k0 < 64; k0 += 32) ao = MFMA16(lfrag(VnT, 16 * et + fr, SK, k0, fq), lfrag(Asm, 16 * it + fr, SK, k0, fq), ao);
    {
        const int gr = c < NCH ? prow(x.b, c, 16 * it + fr) : -1;
        u32x2 w; w.x = pk2(ao[0], ao[1]); w.y = pk2(ao[2], ao[3]);
        *(u32x2*)(gr >= 0 ? (unsigned char*)(x.OA + (size_t)gr * 512 + x.h * 128 + 32 * x.sl + 16 * et + 4 * fq) : x.junk + tid * 8) = w;
        float ss = (ao[0] * ao[0] + ao[1] * ao[1]) + (ao[2] * ao[2] + ao[3] * ao[3]);
        ss += __shfl_xor(ss, 16); ss += __shfl_xor(ss, 32);
        if (fq == 0) *(gr >= 0 ? x.SSO + ((size_t)gr * 8 + x.h) * 8 + 2 * x.sl + et : (float*)(x.junk + tid * 8)) = ss;
    }
#pragma unroll
    for (int t = 0; t < 2; ++t) {
        f32x4 sv = Sacc[t] * egl;
#pragma unroll
        for (int k0 = 0; k0 < 64; k0 += 32) sv = MFMA16(trfrag(KTs, SQ, k0, 16 * wave, fr, fq), lfrag(VnT, 16 * t + fr, SK, k0, fq), sv);
        Sacc[t] = sv;
        u32x2 w; w.x = pk2(sv[0], sv[1]); w.y = pk2(sv[2], sv[3]); *(LAS u32x2*)(St + (16 * t + fr) * SQ + 16 * wave + 4 * fq) = w;
    }
}
__device__ __forceinline__ void p3_scan_delta(const Params& p, LAS unsigned char* lds, int sid) {
    const int tid = threadIdx.x, lane = tid & 63, wave = tid >> 6, fr = lane & 15, fq = lane >> 4;
    const int bh = sid >> 2, sl = sid & 3, h = bh & 3, b = bh >> 2;
    unsigned char* ws = p.ws;
    DCtx x{(const bf16_t*)(ws + WS_QT), (const bf16_t*)(ws + WS_KT), (const bf16_t*)(ws + WS_WW), (const bf16_t*)(ws + WS_UU), (const bf16_t*)(ws + WS_ATTA),
           (const float*)((unsigned char*)p.out + DS_EGL), (bf16_t*)((unsigned char*)p.out + DS_OA), (float*)((unsigned char*)p.out + DS_SSO), ws + WS_ZERO, (const float*)(ws + WS_ONES), ws + WS_JUNK, b, h, bh, sl, tid, wave, fr, fq};
    LAS bf16_t* St = (LAS bf16_t*)(lds + LD_ST);
    for (int e = tid; e < 32 * SQ / 2; e += NTHR) ((LAS unsigned*)St)[e] = 0u;
    f32x4 Sacc[2] = {{0.f, 0.f, 0.f, 0.f}, {0.f, 0.f, 0.f, 0.f}};
    DReg r0, r1;
    delta_prefetch(x, r0, 0); delta_prefetch(x, r1, 1);
    for (int c = 0; c < NCH + 1; c += 2) {
        lds_barrier();
        delta_stage(x, lds, r0); delta_stage(x, lds + LD_BUF, r1);
        const float egl0 = r0.egl, egl1 = r1.egl;
        delta_prefetch(x, r0, c + 2); delta_prefetch(x, r1, c + 3);
        lds_barrier();
        delta_compute(x, lds, lds, c, egl0, Sacc);
        lds_barrier();
        delta_compute(x, lds, lds + LD_BUF, c + 1, egl1, Sacc);
    }
#pragma unroll
    for (int t = 0; t < 2; ++t)
#pragma unroll
        for (int r = 0; r < 4; ++r) p.out[O_DP + ((size_t)bh * 128 + 16 * wave + 4 * fq + r) * 128 + 32 * sl + 16 * t + fr] = Sacc[t][r];
    lds_barrier();
}

constexpr int LG_QS = 0, LG_KT = LG_QS + 64 * SQ * 2, LG_AS = LG_KT + 64 * SQ * 2, LG_VT = LG_AS + 64 * SK * 2, LG_BUF = LG_VT + 64 * SK * 2, LG_ST = 2 * LG_BUF, LG_END = LG_ST + 64 * SQ * 2;
static_assert(LG_END <= LDS_BYTES - 64, "gla scan LDS");
struct GReg { u32x4 rq[2], rk[2], ra, rv; f32x4 dd; };
struct GCtx { const bf16_t *PA, *ATT; const float* EBL; bf16_t* OB; float* SSO; const unsigned char* zero; const float* ones; unsigned char* junk; int b, h, bh, sl, tid, wave, fr, fq; };
__device__ __forceinline__ void gla_prefetch(const GCtx& x, GReg& r, int cc) {
    const bool live = cc < NCH;
    const bf16_t* zp = (const bf16_t*)(x.zero + (x.tid & 255) * 16);
#pragma unroll
    for (int s = 0; s < 2; ++s) { const int pi = x.tid + 512 * s, rr = pi >> 4, c8 = pi & 15; const int gr = live ? prow(x.b, cc, rr) : -1;
        const size_t off = (size_t)(gr >= 0 ? gr : 0) * LDA_ + x.h * 128 + 8 * c8;
        r.rq[s] = *(const u32x4*)(gr >= 0 ? x.PA + off + 1536 : zp); r.rk[s] = *(const u32x4*)(gr >= 0 ? x.PA + off + 2048 : zp); }
    r.ra = *(const u32x4*)(live ? x.ATT + (size_t)(x.bh * NCH + cc) * 4096 + x.tid * 8 : zp);
    { const int rr = x.tid >> 3, c8 = x.tid & 7; const int gr = live ? prow(x.b, cc, rr) : -1;
      r.rv = *(const u32x4*)(gr >= 0 ? x.PA + (size_t)gr * LDA_ + 2560 + x.h * 256 + 64 * x.sl + 8 * c8 : zp); }
    r.dd = *(const f32x4*)(live ? x.EBL + (size_t)(x.bh * NCH + cc) * 128 + 16 * x.wave + 4 * x.fq : x.ones);
}
__device__ __forceinline__ void gla_stage(const GCtx& x, LAS unsigned char* buf, const GReg& r) {
    LAS bf16_t* Qsm = (LAS bf16_t*)(buf + LG_QS); LAS bf16_t* KTs = (LAS bf16_t*)(buf + LG_KT); LAS bf16_t* Asm = (LAS bf16_t*)(buf + LG_AS); LAS bf16_t* VT = (LAS bf16_t*)(buf + LG_VT);
    const int tid = x.tid;
#pragma unroll
    for (int s = 0; s < 2; ++s) { const int pi = tid + 512 * s, rr = pi >> 4, c8 = pi & 15;
        *(LAS u32x4*)(Qsm + rr * SQ + 8 * c8) = r.rq[s]; *(LAS u32x4*)(KTs + rr * SQ + 8 * c8) = r.rk[s]; }
    *(LAS u32x4*)(Asm + (tid >> 3) * SK + (tid & 7) * 8) = r.ra;
    *(LAS u32x4*)(VT + (tid >> 3) * SK + (tid & 7) * 8) = r.rv;
}
__device__ __forceinline__ void gla_compute(const GCtx& x, LAS unsigned char* lds, LAS unsigned char* buf, int c, f32x4 dd, f32x4 (&Sacc)[4]) {
    LAS bf16_t* Qsm = (LAS bf16_t*)(buf + LG_QS); LAS bf16_t* KTs = (LAS bf16_t*)(buf + LG_KT); LAS bf16_t* Asm = (LAS bf16_t*)(buf + LG_AS);
    LAS bf16_t* VT = (LAS bf16_t*)(buf + LG_VT); LAS bf16_t* St = (LAS bf16_t*)(lds + LG_ST);
    const int tid = x.tid, wave = x.wave, fr = x.fr, fq = x.fq, it = wave >> 1, eh = wave & 1;
    const int gr = c < NCH ? prow(x.b, c, 16 * it + fr) : -1;
    float ssq = 0.f;
#pragma unroll
    for (int t = 0; t < 2; ++t) {
        const int et = 2 * eh + t;
        f32x4 ao = {0.f, 0.f, 0.f, 0.f};
#pragma unroll
        for (int k0 = 0; k0 < 128; k0 += 32) ao = MFMA16(lfrag(St, 16 * et + fr, SQ, k0, fq), lfrag(Qsm, 16 * it + fr, SQ, k0, fq), ao);
#pragma unroll
        for (int k0 = 0; k0 < 64; k0 += 32) ao = MFMA16(trfrag(VT, SK, k0, 16 * et, fr, fq), lfrag(Asm, 16 * it + fr, SK, k0, fq), ao);
        { u32x2 w; w.x = pk2(ao[0], ao[1]); w.y = pk2(ao[2], ao[3]); *(u32x2*)(gr >= 0 ? (unsigned char*)(x.OB + (size_t)gr * 1024 + x.h * 256 + 64 * x.sl + 16 * et + 4 * fq) : x.junk + tid * 8) = w; }
        ssq += (ao[0] * ao[0] + ao[1] * ao[1]) + (ao[2] * ao[2] + ao[3] * ao[3]);
    }
    ssq += __shfl_xor(ssq, 16); ssq += __shfl_xor(ssq, 32);
    if (fq == 0) *(gr >= 0 ? x.SSO + ((size_t)gr * 8 + 4 + x.h) * 8 + 2 * x.sl + eh : (float*)(x.junk + tid * 8)) = ssq;
#pragma unroll
    for (int t = 0; t < 4; ++t) {
        f32x4 sv = Sacc[t];
#pragma unroll
        for (int k0 = 0; k0 < 64; k0 += 32) sv = MFMA16(trfrag(KTs, SQ, k0, 16 * wave, fr, fq), trfrag(VT, SK, k0, 16 * t, fr, fq), sv);
        Sacc[t] = sv * dd;
    }
    lds_barrier();
#pragma unroll
    for (int t = 0; t < 4; ++t) { u32x2 w; w.x = pk2(Sacc[t][0], Sacc[t][1]); w.y = pk2(Sacc[t][2], Sacc[t][3]); *(LAS u32x2*)(St + (16 * t + fr) * SQ + 16 * wave + 4 * fq) = w; }
}
__device__ __forceinline__ void p3_scan_gla(const Params& p, LAS unsigned char* lds, int sid) {
    const int tid = threadIdx.x, lane = tid & 63, wave = tid >> 6, fr = lane & 15, fq = lane >> 4;
    const int bh = sid >> 2, sl = sid & 3, h = bh & 3, b = bh >> 2;
    GCtx x{(const bf16_t*)(p.ws + WS_PROJA), (const bf16_t*)((unsigned char*)p.out + DS_ATTB), (const float*)((unsigned char*)p.out + DS_EBL), (bf16_t*)(p.ws + WS_OB), (float*)((unsigned char*)p.out + DS_SSO), p.ws + WS_ZERO, (const float*)(p.ws + WS_ONES), p.ws + WS_JUNK, b, h, bh, sl, tid, wave, fr, fq};
    LAS bf16_t* St = (LAS bf16_t*)(lds + LG_ST);
    for (int e = tid; e < 64 * SQ / 2; e += NTHR) ((LAS unsigned*)St)[e] = 0u;
    f32x4 Sacc[4];
#pragma unroll
    for (int t = 0; t < 4; ++t) Sacc[t] = (f32x4){0.f, 0.f, 0.f, 0.f};
    GReg r0, r1;
    gla_prefetch(x, r0, 0); gla_prefetch(x, r1, 1);
    for (int c = 0; c < NCH + 1; c += 2) {
        lds_barrier();
        gla_stage(x, lds, r0); gla_stage(x, lds + LG_BUF, r1);
        const f32x4 dd0 = r0.dd, dd1 = r1.dd;
        gla_prefetch(x, r0, c + 2); gla_prefetch(x, r1, c + 3);
        lds_barrier();
        gla_compute(x, lds, lds, c, dd0, Sacc);
        lds_barrier();
        gla_compute(x, lds, lds + LG_BUF, c + 1, dd1, Sacc);
    }
#pragma unroll
    for (int t = 0; t < 4; ++t)
#pragma unroll
        for (int r = 0; r < 4; ++r) p.out[O_GP + ((size_t)bh * 128 + 16 * wave + 4 * fq + r) * 256 + 64 * sl + 16 * t + fr] = Sacc[t][r];
    lds_barrier();
}

__device__ __forceinline__ void p_gate(const Params& p) {
    const int tid = threadIdx.x, lane = tid & 63, wave = tid >> 6;
    const int gw = blockIdx.x * 8 + wave, NGW = gridDim.x * 8;
    bf16_t* OA = (bf16_t*)((unsigned char*)p.out + DS_OA); bf16_t* OB = (bf16_t*)(p.ws + WS_OB); const bf16_t* Z = (const bf16_t*)(p.ws + WS_Z);
    for (int row0 = gw; row0 < R; row0 += 2 * NGW) {
        u32x4 oa[2], za[2], ob[2][2], zb[2][2];
#pragma unroll
        for (int u = 0; u < 2; ++u) { const int row = row0 + u * NGW; if (row < R) {
            oa[u] = *(const u32x4*)(OA + (size_t)row * 512 + 8 * lane); za[u] = *(const u32x4*)(Z + (size_t)row * 1536 + 8 * lane);
            const u32x4* op = (const u32x4*)(OB + (size_t)row * 1024 + 16 * lane); const u32x4* zp = (const u32x4*)(Z + (size_t)row * 1536 + 512 + 16 * lane);
            ob[u][0] = op[0]; ob[u][1] = op[1]; zb[u][0] = zp[0]; zb[u][1] = zp[1]; } }
#pragma unroll
        for (int u = 0; u < 2; ++u) { const int row = row0 + u * NGW; if (row < R) {
            {
                float o[8], z[8]; unpack8(oa[u], o); unpack8(za[u], z);
                float s = 0.f;
#pragma unroll
                for (int e = 0; e < 8; ++e) s += o[e] * o[e];
                s += __shfl_xor(s, 1); s += __shfl_xor(s, 2); s += __shfl_xor(s, 4); s += __shfl_xor(s, 8);
                const float rs = rsqrtf(s * (1.f / 128.f) + EPS); const float* nw = p.in[I_ONA] + 8 * (lane & 15);
#pragma unroll
                for (int e = 0; e < 8; ++e) o[e] = o[e] * rs * nw[e] * siluf_(z[e]);
                *(u32x4*)(OA + (size_t)row * 512 + 8 * lane) = pack8(o);
            }
            {
                float o[16], z[16]; unpack8(ob[u][0], o); unpack8(ob[u][1], o + 8); unpack8(zb[u][0], z); unpack8(zb[u][1], z + 8);
                float s = 0.f;
#pragma unroll
                for (int e = 0; e < 16; ++e) s += o[e] * o[e];
                s += __shfl_xor(s, 1); s += __shfl_xor(s, 2); s += __shfl_xor(s, 4); s += __shfl_xor(s, 8);
                const float rs = rsqrtf(s * (1.f / 256.f) + EPS); const float* nw = p.in[I_ONB] + 16 * (lane & 15);
#pragma unroll
                for (int e = 0; e < 16; ++e) o[e] = o[e] * rs * nw[e] * siluf_(z[e]);
                u32x4* op = (u32x4*)(OB + (size_t)row * 1024 + 16 * lane); op[0] = pack8(o); op[1] = pack8(o + 8);
            }
        } }
    }
}
__device__ __forceinline__ void p_act(const Params& p) {
    const bf16_t* U = (const bf16_t*)(p.ws + WS_U); bf16_t* GF = (bf16_t*)(p.ws + WS_GF);
    const float* wf = p.in[I_WCF]; const float* bfc = p.in[I_BCF];
    const int gt = blockIdx.x * NTHR + threadIdx.x, NGT = gridDim.x * NTHR;
    constexpr int NC8 = DFF / 8, NSTRIP = RP / 8;
    for (int wi = gt; wi < (NSTRIP + NDEC) * NC8; wi += NGT) {
        const int c8 = wi % NC8, st = wi / NC8, col = 8 * c8;
        float w0[8], w1[8], w2[8], bb[8];
        {
            const f32x4 a0 = *(const f32x4*)(wf + col), a1 = *(const f32x4*)(wf + col + 4), b0 = *(const f32x4*)(wf + DFF + col), b1 = *(const f32x4*)(wf + DFF + col + 4);
            const f32x4 c0 = *(const f32x4*)(wf + 2 * DFF + col), c1 = *(const f32x4*)(wf + 2 * DFF + col + 4), d0 = *(const f32x4*)(bfc + col), d1 = *(const f32x4*)(bfc + col + 4);
#pragma unroll
            for (int e = 0; e < 4; ++e) { w0[e] = a0[e]; w0[4 + e] = a1[e]; w1[e] = b0[e]; w1[4 + e] = b1[e]; w2[e] = c0[e]; w2[4 + e] = c1[e]; bb[e] = d0[e]; bb[4 + e] = d1[e]; }
        }
        if (st < NSTRIP) {
            const int r0 = st * 8; float p2[8], p1[8];
            int ra = -1, rb = -1;
            if (r0 < RMAIN) { if ((r0 & (SEQ - 1)) == 0) { const int b = r0 / SEQ; ra = RMETA0 + b * 16 + 14; rb = ra + 1; } else { ra = r0 - 2; rb = r0 - 1; } }
            else if (((r0 - RMETA0) & 15) != 0) { ra = r0 - 2; rb = r0 - 1; }
            if (ra >= 0) { unpack8(*(const u32x4*)(U + (size_t)ra * DFF + col), p2); unpack8(*(const u32x4*)(U + (size_t)rb * DFF + col), p1); }
            else {
#pragma unroll
                for (int e = 0; e < 8; ++e) { p2[e] = 0.f; p1[e] = 0.f; } }
            for (int rr = 0; rr < 8; rr += 8) {
                u32x4 ur[8], gr[8];
#pragma unroll
                for (int q = 0; q < 8; ++q) { ur[q] = *(const u32x4*)(U + (size_t)(r0 + rr + q) * DFF + col); gr[q] = *(const u32x4*)(GF + (size_t)(r0 + rr + q) * DFF + col); }
#pragma unroll
                for (int q = 0; q < 8; ++q) {
                    const int row = r0 + rr + q; float u[8], g[8], o[8];
                    unpack8(ur[q], u); unpack8(gr[q], g);
#pragma unroll
                    for (int e = 0; e < 8; ++e) { o[e] = gelu_tanh(w0[e] * p2[e] + w1[e] * p1[e] + w2[e] * u[e] + bb[e]) * g[e]; p2[e] = p1[e]; p1[e] = u[e]; }
                    *(u32x4*)(GF + (size_t)row * DFF + col) = pack8(o);
                    if (row < RMAIN && (row & (SEQ - 1)) >= SEQ - 2) { float* so = p.out + O_FCP + ((size_t)(row / SEQ) * 2 + ((row & (SEQ - 1)) - (SEQ - 2))) * DFF + col;
#pragma unroll
                        for (int e = 0; e < 8; ++e) so[e] = u[e]; }
                }
            }
        } else {
            const int n = st - NSTRIP, row = RDEC0 + n; float u[8], g[8], o[8];
            const float* s0 = p.in[I_SFC] + (size_t)n * 2 * DFF + col; const float* s1 = s0 + DFF;
            unpack8(*(const u32x4*)(U + (size_t)row * DFF + col), u); unpack8(*(const u32x4*)(GF + (size_t)row * DFF + col), g);
            float* so = p.out + O_FCS + (size_t)n * 2 * DFF + col;
#pragma unroll
            for (int e = 0; e < 8; ++e) { o[e] = gelu_tanh(w0[e] * s0[e] + w1[e] * s1[e] + w2[e] * u[e] + bb[e]) * g[e]; so[e] = s1[e]; so[DFF + e] = u[e]; }
            *(u32x4*)(GF + (size_t)row * DFF + col) = pack8(o);
        }
    }
}
__device__ __forceinline__ void p_final(const Params& p) {
    const float* SS3 = (const float*)(p.ws + WS_SS3); const float* nw = p.in[I_NFIN];
    const int gt = blockIdx.x * NTHR + threadIdx.x, NGT = gridDim.x * NTHR;
    constexpr int NIT = (RMAIN + NDEC) * 256;
    for (int w0 = gt; w0 < NIT; w0 += 8 * NGT) {
        f32x4 v[8]; f32x4* o[8]; float rs[8];
#pragma unroll
        for (int u = 0; u < 8; ++u) { const int wi = w0 + u * NGT; if (wi < NIT) { int row = wi >> 8; if (row >= RMAIN) row += (RDEC0 - RMAIN); o[u] = (f32x4*)(p.out + yslot(row)) + (wi & 255); v[u] = *o[u]; rs[u] = SS3[row]; } }
#pragma unroll
        for (int u = 0; u < 8; ++u) { const int wi = w0 + u * NGT; if (wi < NIT) { const float r = rsqrtf(rs[u] * (1.f / D) + EPS); const f32x4 w = ((const f32x4*)nw)[wi & 255];
            f32x4 t = v[u]; t.x *= r * w.x; t.y *= r * w.y; t.z *= r * w.z; t.w *= r * w.w; *o[u] = t; } }
    }
}

#define XB_TMO      128
#define XB_XCNT(j)  (256  + 64 * (j))
#define XB_XSUB(j)  (1280 + 64 * (j))
#define XB_XGEN(j)  (2304 + 64 * (j))
#define XB_TOP      3328
#define XB_TOPGEN   3392
#define XCD_BAR_WORDS 3456
#define XB_SPIN_CAP (1u << 18)

__device__ __forceinline__ unsigned xb_ld(unsigned* p)              { return __hip_atomic_load(p, __ATOMIC_RELAXED, __HIP_MEMORY_SCOPE_AGENT); }
__device__ __forceinline__ unsigned xb_add(unsigned* p, unsigned v) { return __hip_atomic_fetch_add(p, v, __ATOMIC_RELAXED, __HIP_MEMORY_SCOPE_AGENT); }
__device__ __forceinline__ unsigned xb_xcc_id() { return (unsigned)__builtin_amdgcn_s_getreg((3 << 11) | 20) & 0xFu; }
#define XB_SPIN(cond, bar) do { unsigned _sp = 0; while (cond) { __builtin_amdgcn_s_sleep(1); \
    if ((++_sp & 255u) == 0u) { if (xb_ld(&(bar)[XB_TMO])) break; if (_sp > XB_SPIN_CAP) { atomicAdd(&(bar)[XB_TMO], 1u); break; } } } } while (0)

struct XcdBarrier {
    unsigned* bar; unsigned x;
    volatile LAS unsigned* st;
};

__device__ __forceinline__ XcdBarrier xcd_barrier_post(unsigned* bar, volatile LAS unsigned* st) {
    XcdBarrier b; b.bar = bar; b.x = xb_xcc_id(); b.st = st;
    if (threadIdx.x == 0) (void)xb_add(&bar[XB_XCNT(b.x)], 1u);
    return b;
}
__device__ __forceinline__ void xcd_barrier_complete(unsigned* bar, unsigned x, unsigned& nloc, unsigned& nx) {
    const unsigned G = gridDim.x * gridDim.y * gridDim.z;
    unsigned sum, cnt, mine, sp = 0u;
    for (;;) {
        sum = 0u; cnt = 0u; mine = 0u;
#pragma unroll
        for (unsigned j = 0; j < 16; ++j) { const unsigned c = xb_ld(&bar[XB_XCNT(j)]); sum += c; cnt += (c > 0u) ? 1u : 0u; mine = (j == x) ? c : mine; }
        if (sum == G) break;
        __builtin_amdgcn_s_sleep(1);
        if ((++sp & 255u) == 0u) { if (xb_ld(&bar[XB_TMO])) break; if (sp > XB_SPIN_CAP) { atomicAdd(&bar[XB_TMO], 1u); break; } }
    }
    nloc = mine > 0u ? mine : 1u; nx = cnt > 0u ? cnt : 1u;
}

__device__ __forceinline__ void xcd_barrier(const XcdBarrier& b) {
    asm volatile("s_waitcnt vmcnt(0)" ::: "memory");
    __syncthreads();
    if (threadIdx.x == 0) {
        unsigned* bar = b.bar;
        __builtin_amdgcn_s_waitcnt(0);
        unsigned nloc = b.st[0], nx = b.st[1];
        if (nloc == 0u) { xcd_barrier_complete(bar, b.x, nloc, nx); b.st[0] = nloc; b.st[1] = nx; }
        const unsigned old = xb_add(&bar[XB_XSUB(b.x)], 1u);
        const unsigned gen = old / nloc;
        if (old + 1u == (gen + 1u) * nloc) {
            __builtin_amdgcn_fence(__ATOMIC_RELEASE, "agent");
            asm volatile("s_waitcnt vmcnt(0)" ::: "memory");
            const unsigned og = xb_add(&bar[XB_TOP], 1u);
            const unsigned tg = og / nx;
            if (og + 1u == (tg + 1u) * nx) xb_add(&bar[XB_TOPGEN], 1u);
            else XB_SPIN(xb_ld(&bar[XB_TOPGEN]) == tg, bar);
            __builtin_amdgcn_fence(__ATOMIC_ACQUIRE, "agent");
            xb_add(&bar[XB_XGEN(b.x)], 1u);
            asm volatile("s_waitcnt vmcnt(0)" ::: "memory");
        } else {
            XB_SPIN(xb_ld(&bar[XB_XGEN(b.x)]) == gen, bar);
            __builtin_amdgcn_fence(__ATOMIC_ACQUIRE, "agent");
            asm volatile("s_waitcnt vmcnt(0)" ::: "memory");
        }
    }
    __syncthreads();
}


constexpr int NPHASE = 12;
#ifndef PROBE_MASK
#define PROBE_MASK 0
#endif
#define REPS(k) for (int rep_ = 0; rep_ <= ((PROBE_MASK >> (k)) & 1); ++rep_)
__global__ void __launch_bounds__(NTHR, 2) fwd_kernel(Params p) {
    extern __shared__ __attribute__((aligned(16))) unsigned char lds_raw[];
    LAS unsigned char* lds = (LAS unsigned char*)lds_raw;
    cg::grid_group grid = cg::this_grid();
    volatile LAS unsigned* bst = (volatile LAS unsigned*)(lds + LDS_BYTES - 64);
    if (threadIdx.x == 0) { bst[0] = 0u; bst[1] = 0u; }
    __syncthreads();
    XcdBarrier bar; bar.bar = (unsigned*)(p.ws + WS_BAR); bar.x = 0; bar.st = bst;
    if (p.ph_hi - p.ph_lo > 1 && blockIdx.x == 0) for (int e = threadIdx.x; e < XCD_BAR_WORDS; e += NTHR) __hip_atomic_store((unsigned*)(p.ws + WS_BAR) + e, 0u, __ATOMIC_RELAXED, __HIP_MEMORY_SCOPE_AGENT);
    unsigned char* ws = p.ws; unsigned char* ob = (unsigned char*)p.out;
    const int lo = p.ph_lo, hi = p.ph_hi, G = gridDim.x;
#define IN(k) (lo <= (k) && (k) < hi)
#ifdef PROBE_TS_MASK
    unsigned long long ts_[NPHASE + 1]; ts_[0] = __builtin_amdgcn_s_memrealtime();
#ifdef PROBE_TX
    unsigned long long tx_[4] = {0, 0, 0, 0};
#endif
#define SEAM(k) do { if (IN(k) && IN((k) + 1)) xcd_barrier(bar); ts_[(k) + 1] = __builtin_amdgcn_s_memrealtime(); } while (0)
#else
#define SEAM(k) do { if (IN(k) && IN((k) + 1)) xcd_barrier(bar); } while (0)
#endif
    if (IN(0)) REPS(0) { p0_prologue(p, lds); }
    if (IN(0) && IN(1)) { __threadfence(); grid.sync(); bar = xcd_barrier_post((unsigned*)(p.ws + WS_BAR), bst); }
#ifdef PROBE_TS_MASK
    ts_[1] = __builtin_amdgcn_s_memrealtime();
#endif
#ifdef PROBE_XSYNC
    for (int i = 0; i < PROBE_XSYNC; ++i) xcd_barrier(bar);
#endif
    if (IN(1)) REPS(1) {
        pg8::Gemm g{(const bf16_t*)(ob + DS_HN), (const bf16_t*)(ws + WS_WTA), R, NA, 1024}; pg8::StaticOrder S; S.init(R, NA, G, (int)blockIdx.x);
        pg8::Epi8<FA> E{FA{(bf16_t*)(ws + WS_PROJA), (float*)(ob + DS_SMALL)}};
        pg8::gemm_phase<pg8::Epi8<FA>, pg8::StaticOrder, true, true>(lds, g, S, E);
        transposes_in_idle_slots<6, 9>(p, lds, (R / 256) * (NA / 256));
    }
    SEAM(1);
    if (IN(2)) REPS(2) {
#ifdef PROBE_TX
        bool st_ = false;
#endif
        for (int it = blockIdx.x; it < 2 * NITEM; it += G) {
#ifdef PROBE_TX
            if (it >= NITEM && !st_) { st_ = true; tx_[0] = __builtin_amdgcn_s_memrealtime(); }
#endif
            if (it < NITEM) p2_delta_item(p, lds, it); else p2_gla_item(p, lds, it - NITEM); }
#ifdef PROBE_TX
        tx_[1] = __builtin_amdgcn_s_memrealtime();
#endif
    }
    SEAM(2);
    if (IN(3)) REPS(3) {
        p3_decode(p, lds);
#ifdef PROBE_TX
        tx_[2] = __builtin_amdgcn_s_memrealtime();
#endif
        const int vb = (G % 8 == 0) ? (int)(blockIdx.x % 8) * (G / 8) + (int)blockIdx.x / 8 : (int)blockIdx.x;
        for (int sid = vb; sid < 256; sid += G) { if (sid < 128) p3_scan_delta(p, lds, sid); else p3_scan_gla(p, lds, sid - 128); }
#ifdef PROBE_TX
        tx_[3] = __builtin_amdgcn_s_memrealtime();
#endif
    }
    SEAM(3);
    if (IN(4)) REPS(4) {
        pg8::Gemm g{(const bf16_t*)(ob + DS_HN), (const bf16_t*)(ws + WS_WTB), R, NBW, 1024}; pg8::StaticOrder S; S.init(R, NBW, G, (int)blockIdx.x);
        pg8::Epi8<FB> E{FB{(bf16_t*)(ob + DS_OA), (bf16_t*)(ws + WS_OB), (const float*)(ob + DS_SSO), p.in[I_ONA], p.in[I_ONB], (bf16_t*)(ws + WS_SG)}};
        pg8::gemm_phase<pg8::Epi8<FB>, pg8::StaticOrder, true, true>(lds, g, S, E);
        transposes_in_idle_slots<9, 11>(p, lds, (R / 256) * (NBW / 256));
    }
    SEAM(4);
    if (IN(6)) REPS(6) {
        {
            pg8::Gemm g{(const bf16_t*)(ob + DS_OA), (const bf16_t*)(ws + WS_WA), RMAIN, 1024, 512}; pg8::StaticOrder S; S.init(RMAIN, 1024, G, (int)blockIdx.x);
            FMix<0> f{(const bf16_t*)(ws + WS_SG), (bf16_t*)(ws + WS_MIX)}; pg8::Epi8<FMix<0>> E{f};
            pg8::gemm_phase<pg8::Epi8<FMix<0>>, pg8::StaticOrder, true, true>(lds, g, S, E);
            thin_gemm(lds, g.A, g.Bt, 512, 1024, RMAIN, f);
        }
        {
            pg8::Gemm g{(const bf16_t*)(ws + WS_OB), (const bf16_t*)(ws + WS_WB), RMAIN, 1024, 1024}; pg8::StaticOrder S; S.init(RMAIN, 1024, G, (int)blockIdx.x);
            FMix<1> f{(const bf16_t*)(ws + WS_SG), (bf16_t*)(ws + WS_MIX)}; pg8::Epi8<FMix<1>> E{f};
            pg8::gemm_phase<pg8::Epi8<FMix<1>>, pg8::StaticOrder, true, true>(lds, g, S, E);
            thin_gemm(lds, g.A, g.Bt, 1024, 1024, RMAIN, f);
        }
    }
    SEAM(6);
    if (IN(7)) REPS(7) {
        pg8::Gemm g{(const bf16_t*)(ws + WS_MIX), (const bf16_t*)(ws + WS_WO), RMAIN, 1024, 1024}; pg8::StaticOrder S; S.init(RMAIN, 1024, G, (int)blockIdx.x);
        FX2 f{p.in[I_XP], p.in[I_META], p.in[I_XS], p.out, p.in[I_NFFN], (bf16_t*)(ws + WS_HN2), (float*)(ws + WS_SS2)}; pg8::Epi8<FX2> E{f};
        pg8::gemm_phase<pg8::Epi8<FX2>, pg8::StaticOrder, true, true>(lds, g, S, E);
        thin_gemm(lds, g.A, g.Bt, 1024, 1024, RMAIN, f);
    }
    SEAM(7);
    if (IN(8)) REPS(8) {
        pg8::Gemm g{(const bf16_t*)(ws + WS_HN2), (const bf16_t*)(ws + WS_WF1), R, 5632, 1024}; pg8::StaticOrder S; S.init(R, 5632, G, (int)blockIdx.x);
        EpiAct E{ws, p.in[I_WCF], p.in[I_BCF]};
        pg8::gemm_phase<EpiAct, pg8::StaticOrder, true, true>(lds, g, S, E);
    }
    SEAM(8);
    if (IN(9)) REPS(9) { p_fix(p); }
    SEAM(9);
    if (IN(10)) REPS(10) {
        pg8::Gemm g{(const bf16_t*)(ws + WS_GF), (const bf16_t*)(ws + WS_WF2), RMAIN, 1024, DFF}; pg8::StaticOrder S; S.init(RMAIN, 1024, G, (int)blockIdx.x);
        FF2 f{p.out, (float*)(ws + WS_SS3)}; pg8::Epi8<FF2> E{f};
        pg8::gemm_phase<pg8::Epi8<FF2>, pg8::StaticOrder, true, true>(lds, g, S, E);
        thin_gemm<FF2, true>(lds, g.A, g.Bt, DFF, 1024, RMAIN, f);
    }
    SEAM(10);
    if (IN(11)) REPS(11) { p_final(p); }
#ifdef PROBE_TS_MASK
    ts_[NPHASE] = __builtin_amdgcn_s_memrealtime();
#ifndef PROBE_BLK
#define PROBE_BLK 0
#endif
    if (blockIdx.x == PROBE_BLK) {
        unsigned long long tt = 0;
#pragma unroll
        for (int k = 0; k < NPHASE; ++k) if ((PROBE_TS_MASK >> k) & 1) tt += ts_[k + 1] - ts_[k];
#ifdef PROBE_TX
        if (PROBE_TX == 1) tt = tx_[0] - ts_[2];
        if (PROBE_TX == 2) tt = tx_[1] - tx_[0];
        if (PROBE_TX == 3) tt = tx_[2] - ts_[3];
        if (PROBE_TX == 4) tt = tx_[3] - tx_[2];
#endif
        const float T_us = (float)tt * 0.01f;
        const float sc = 1.f + sqrtf(4e-5f + T_us * 2.5e-7f);
        for (int e = threadIdx.x; e < 36864; e += NTHR) p.out[O_DCP + e] *= sc;
    }
#endif
#undef IN
#undef SEAM
}

#ifndef N_LAUNCH_MODE
#define N_LAUNCH_MODE 1
#endif
extern "C" void kernel_launch(void* const* d_in, const int* in_sizes, int n_in, void* d_out, int out_size, void* d_ws, size_t ws_size, hipStream_t stream) {
    static int grid = 0;
    if (grid == 0) {
        int dev = 0, cus = 0, per_cu = 0;
        hipGetDevice(&dev); hipDeviceGetAttribute(&cus, hipDeviceAttributeMultiprocessorCount, dev);
        hipFuncSetAttribute((const void*)fwd_kernel, hipFuncAttributeMaxDynamicSharedMemorySize, LDS_BYTES);
        hipOccupancyMaxActiveBlocksPerMultiprocessor(&per_cu, (const void*)fwd_kernel, NTHR, LDS_BYTES);
        if (per_cu < 1) { fprintf(stderr, "occupancy query says %d blocks/CU\n", per_cu); per_cu = 1; }
        grid = cus * 1;
        if (n_in != 25 || (size_t)out_size != O_END || ws_size < 256 * MiB) fprintf(stderr, "kernel_launch: unexpected sizes n_in %d out %d ws %zu\n", n_in, out_size, ws_size);
    }
    Params p{};
    for (int i = 0; i < 25; ++i) p.in[i] = (const float*)d_in[i];
    p.out = (float*)d_out; p.ws = (unsigned char*)d_ws;
#if N_LAUNCH_MODE == 1
    p.ph_lo = 0; p.ph_hi = NPHASE;
    void* args[] = {&p};
    hipError_t e = hipLaunchCooperativeKernel((const void*)fwd_kernel, dim3(grid), dim3(NTHR), args, LDS_BYTES, stream);
    if (e != hipSuccess) fprintf(stderr, "cooperative launch failed: %s (grid %d)\n", hipGetErrorString(e), grid);
#else
    for (int k = 0; k < NPHASE; ++k) { p.ph_lo = k; p.ph_hi = k + 1; hipLaunchKernelGGL(fwd_kernel, dim3(grid), dim3(NTHR), LDS_BYTES, stream, p); }
#endif
}
```
